# Optimizing an MI355X kernel written in HIP

```python
import math
import jax
import jax.numpy as jnp
from jax import lax
import numpy as np

D_MODEL = 2048
BATCH = 4
SEQ = 2048
DEPTH = 4
DEC_BATCH = 128
DEC_SEQ = 4
PAST_LEN = 16384
PAGE_SIZE = 128

N_META = 16
GROUP_WIDTH = D_MODEL // 4
EPS = 1e-6
R_HEAD_DIM = 64
R_HEADS = GROUP_WIDTH // R_HEAD_DIM
R_WIDTH = R_HEADS * R_HEAD_DIM
R_DECAY_RANK = 64
R_ICL_RANK = 64
R_GATE_RANK = 128
R_COLS = 3 * R_WIDTH + R_DECAY_RANK + R_ICL_RANK + R_GATE_RANK
RWKV_DECAY_SCALE = 0.606531
RWKV_GN_EPS = 64e-5
S5_GROUP_CH = 16
S5_GROUPS = GROUP_WIDTH // S5_GROUP_CH
S5_WIDTH = S5_GROUPS * S5_GROUP_CH
S5_STATE = 64
S5_COLS = S5_WIDTH
H_HEAD_DIM = 128
H_HEADS = GROUP_WIDTH // H_HEAD_DIM
H_WIDTH = H_HEADS * H_HEAD_DIM
H_COLS = 4 * H_WIDTH
HGRN_MAX_INPUT = 1.0 - 1e-4
G_VAL_DIM = 128
G_HEADS = GROUP_WIDTH // G_VAL_DIM
G_KEY_DIM = G_VAL_DIM // 2
G_WIDTH = G_HEADS * G_VAL_DIM
G_QK = G_HEADS * G_KEY_DIM
G_GATE_RANK = 16
G_COLS = 2 * G_QK + G_WIDTH + G_GATE_RANK + G_WIDTH
GLA_GATE_NORM = 16.0

MIX_WIDTH = R_WIDTH + S5_WIDTH + H_WIDTH + G_WIDTH
IN_COLS = R_COLS + S5_COLS + H_COLS + G_COLS
CHUNK = 16
D_FF = ((8 * D_MODEL // 3 + 127) // 128) * 128
CONV_W = 3

kernel_name = 'hybrid_rwkv7_s5_hgrn2_gla_decode_step'


def _rmsnorm(x, g):
    xf = x.astype(jnp.float32)
    y = xf * lax.rsqrt(jnp.mean(xf * xf, axis=-1, keepdims=True) + EPS)
    return (y * g.astype(jnp.float32)).astype(x.dtype)


def _head_rmsnorm(o, g):
    y = o * lax.rsqrt(jnp.mean(o * o, axis=-1, keepdims=True) + EPS)
    return y * g.astype(jnp.float32).reshape(o.shape[-2:])


def _rwkv7_mix(p, shift_prev, S0, mu, w0, w_up, a0, a_up, g_up, k_k, k_a, r_k, ln_g):
    f32 = jnp.float32
    Bn, T, _ = p.shape
    pf = p.astype(f32)
    p_prev = jnp.concatenate([shift_prev.astype(f32)[:, None, :], pf[:, :-1]], axis=1)
    ps = pf + (p_prev - pf) * mu.astype(f32)
    W = R_WIDTH
    r, k, v, w_lo, a_lo, g_lo = jnp.split(
        ps, [W, 2 * W, 3 * W, 3 * W + R_DECAY_RANK, 3 * W + R_DECAY_RANK + R_ICL_RANK], axis=-1)
    log_w = -RWKV_DECAY_SCALE * jax.nn.sigmoid(w0.astype(f32) + jnp.tanh(w_lo) @ w_up.astype(f32))
    a = jax.nn.sigmoid(a0.astype(f32) + a_lo @ a_up.astype(f32))
    g = jax.nn.sigmoid(g_lo) @ g_up.astype(f32)
    hs = lambda t: t.reshape(Bn, T, R_HEADS, R_HEAD_DIM)
    r, k, v, w, a = hs(r), hs(k), hs(v), hs(jnp.exp(log_w)), hs(a)
    kk = k * k_k.astype(f32).reshape(R_HEADS, R_HEAD_DIM)
    kk = kk / jnp.maximum(jnp.sqrt(jnp.sum(kk * kk, axis=-1, keepdims=True)), 1e-12)
    k = k * (1.0 + (a - 1.0) * k_a.astype(f32).reshape(R_HEADS, R_HEAD_DIM))
    ka = kk * a

    def step(S, inp):
        r_t, w_t, k_t, v_t, kk_t, ka_t = inp
        sa = jnp.einsum('bhvk,bhk->bhv', S, kk_t)
        S = (S * w_t[:, :, None, :] - sa[..., None] * ka_t[:, :, None, :]
             + v_t[..., None] * k_t[:, :, None, :])
        return S, jnp.einsum('bhvk,bhk->bhv', S, r_t)

    tm = lambda t: jnp.moveaxis(t, 1, 0)
    S, y = lax.scan(step, S0.astype(f32), (tm(r), tm(w), tm(k), tm(v), tm(kk), tm(ka)))
    y = jnp.moveaxis(y, 0, 1)
    mean = jnp.mean(y, axis=-1, keepdims=True)
    var = jnp.mean((y - mean) ** 2, axis=-1, keepdims=True)
    y = (y - mean) * lax.rsqrt(var + RWKV_GN_EPS) * ln_g.astype(f32).reshape(R_HEADS, R_HEAD_DIM)
    y = y + jnp.sum(r * k * r_k.astype(f32), axis=-1, keepdims=True) * v
    out = y.reshape(Bn, T, R_WIDTH) * g
    return out.astype(p.dtype), p[:, -1].astype(shift_prev.dtype), S.astype(S0.dtype)


def _complex_affine_combine(e1, e2):
    a1r, a1i, b1r, b1i = e1
    a2r, a2i, b2r, b2i = e2
    return (a2r * a1r - a2i * a1i,
            a2r * a1i + a2i * a1r,
            a2r * b1r - a2i * b1i + b2r,
            a2r * b1i + a2i * b1r + b2i)


def _s5_mix(u, h0_re, h0_im, A_re, A_im, log_dt, B_re, B_im, C_re, C_im, D, w_glu, b_glu):
    f32 = jnp.float32
    Bn, T, _ = u.shape
    uf = u.astype(f32)
    ug = uf.reshape(Bn, T, S5_GROUPS, S5_GROUP_CH)
    A_re = A_re.astype(f32)
    A_im = A_im.astype(f32)
    dt = jnp.exp(log_dt.astype(f32))[:, None]
    mag = jnp.exp(A_re * dt)
    ab_re = mag * jnp.cos(A_im * dt)
    ab_im = mag * jnp.sin(A_im * dt)
    den = A_re * A_re + A_im * A_im
    n_re = ab_re - 1.0
    co_re = (n_re * A_re + ab_im * A_im) / den
    co_im = (ab_im * A_re - n_re * A_im) / den
    B_re = B_re.astype(f32)
    B_im = B_im.astype(f32)
    bb_re = co_re[..., None] * B_re - co_im[..., None] * B_im
    bb_im = co_re[..., None] * B_im + co_im[..., None] * B_re
    bu_re = jnp.einsum('btgc,gpc->btgp', ug, bb_re)
    bu_im = jnp.einsum('btgc,gpc->btgp', ug, bb_im)
    a_re = jnp.broadcast_to(ab_re, bu_re.shape)
    a_im = jnp.broadcast_to(ab_im, bu_im.shape)
    cum_re, cum_im, h_re, h_im = lax.associative_scan(
        _complex_affine_combine, (a_re, a_im, bu_re, bu_im), axis=1)
    h0r = h0_re.astype(f32)[:, None]
    h0i = h0_im.astype(f32)[:, None]
    h_re = h_re + cum_re * h0r - cum_im * h0i
    h_im = h_im + cum_re * h0i + cum_im * h0r
    y = (jnp.einsum('btgp,gcp->btgc', h_re, C_re.astype(f32))
         - jnp.einsum('btgp,gcp->btgc', h_im, C_im.astype(f32)))
    y = y.reshape(Bn, T, S5_WIDTH) + D.astype(f32) * uf
    y = jax.nn.gelu(y)
    y = y * jax.nn.sigmoid(y @ w_glu.astype(f32) + b_glu.astype(f32))
    return (y.astype(u.dtype), h_re[:, -1].astype(h0_re.dtype), h_im[:, -1].astype(h0_im.dtype))


def _chunked_gla(q, k, v, log_f, S0):
    f32 = jnp.float32
    Bn, T, H, _ = q.shape
    V = v.shape[-1]
    n_chunks = -(-T // CHUNK)
    pad = n_chunks * CHUNK - T

    def to_chunks(a):
        a = jnp.pad(a.astype(f32), ((0, 0), (0, pad), (0, 0), (0, 0)))
        return jnp.moveaxis(a.reshape(Bn, n_chunks, CHUNK, H, a.shape[-1]), 1, 0)

    causal = jnp.tril(jnp.ones((CHUNK, CHUNK), dtype=bool))[None, :, :, None, None]

    def step(S, inp):
        qi, ki, vi, gi = inp
        b = jnp.cumsum(gi, axis=1)
        b_last = b[:, -1]
        o_inter = jnp.einsum('bchk,bhkv->bchv', qi * jnp.exp(b), S)
        diff = jnp.where(causal, b[:, :, None] - b[:, None, :], 0.0)
        decay = jnp.where(causal, jnp.exp(diff), 0.0)
        att = jnp.einsum('bihk,bjhk,bijhk->bhij', qi, ki, decay)
        o_intra = jnp.einsum('bhij,bjhv->bihv', att, vi)
        S_new = (S * jnp.exp(b_last)[..., None]
                 + jnp.einsum('bchk,bchv->bhkv', ki * jnp.exp(b_last[:, None] - b), vi))
        return S_new, o_inter + o_intra

    S, o = lax.scan(step, S0.astype(f32),
                    (to_chunks(q), to_chunks(k), to_chunks(v), to_chunks(log_f)))
    o = jnp.moveaxis(o, 0, 1).reshape(Bn, n_chunks * CHUNK, H, V)[:, :T]
    return o, S


def _hgrn2_mix(p, S0, lb, norm_g):
    f32 = jnp.float32
    Bn, T, _ = p.shape
    q, f_raw, i, g = jnp.split(p.astype(f32), 4, axis=-1)
    lb = lb.astype(f32)
    k = jnp.minimum((1.0 - lb) * jax.nn.sigmoid(-f_raw), HGRN_MAX_INPUT)
    log_f = jnp.log1p(-k)
    hs = lambda t: t.reshape(Bn, T, H_HEADS, H_HEAD_DIM)
    o, S = _chunked_gla(hs(jax.nn.silu(q)), hs(k), hs(i), hs(log_f), S0)
    o = _head_rmsnorm(o, norm_g) * hs(jax.nn.silu(g))
    return o.reshape(Bn, T, H_WIDTH).astype(p.dtype), S.astype(S0.dtype)


def _gla_mix(p, S0, gk_up, gk_b, norm_g):
    f32 = jnp.float32
    Bn, T, _ = p.shape
    q, k, v, gk_lo, gate = jnp.split(
        p.astype(f32), [G_QK, 2 * G_QK, 2 * G_QK + G_WIDTH, 2 * G_QK + G_WIDTH + G_GATE_RANK], axis=-1)
    log_g = jax.nn.log_sigmoid(gk_lo @ gk_up.astype(f32) + gk_b.astype(f32)) / GLA_GATE_NORM
    hk = lambda t: t.reshape(Bn, T, G_HEADS, G_KEY_DIM)
    hv = lambda t: t.reshape(Bn, T, G_HEADS, G_VAL_DIM)
    o, S = _chunked_gla(hk(q) * (G_KEY_DIM ** -0.5), hk(k), hv(v), hk(log_g), S0)
    o = _head_rmsnorm(o, norm_g) * hv(jax.nn.silu(gate))
    return o.reshape(Bn, T, G_WIDTH).astype(p.dtype), S.astype(S0.dtype)


def _conv_ffn(x, buf, w_up, conv_w, conv_b, w_down):
    T = x.shape[1]
    u, gate = jnp.split(x @ w_up, 2, axis=-1)
    u_ext = jnp.concatenate([buf.astype(u.dtype), u], axis=1)
    c = conv_b
    for j in range(CONV_W):
        c = c + conv_w[j] * u_ext[:, j:j + T]
    out = (jax.nn.gelu(c) * gate) @ w_down
    return out.astype(x.dtype), u_ext[:, T:].astype(buf.dtype)


def _layer(x, st, prm, lb):
    rw_S, rw_shift, s5_re, s5_im, hg_S, gl_S, ffn_buf = st
    h = _rmsnorm(x, prm['norm_mix'])
    p = h @ prm['w_in']
    p_r, p_s5, p_h, p_g = jnp.split(
        p, [R_COLS, R_COLS + S5_COLS, R_COLS + S5_COLS + H_COLS], axis=-1)
    y_r, rw_shift_new, rw_S_new = _rwkv7_mix(
        p_r, rw_shift, rw_S, prm['rwkv_mu'], prm['rwkv_w0'], prm['rwkv_w_up'], prm['rwkv_a0'],
        prm['rwkv_a_up'], prm['rwkv_g_up'], prm['rwkv_k_k'], prm['rwkv_k_a'], prm['rwkv_r_k'],
        prm['rwkv_ln'])
    y_s5, s5_re_new, s5_im_new = _s5_mix(
        p_s5, s5_re, s5_im, prm['s5_A_re'], prm['s5_A_im'], prm['s5_log_dt'], prm['s5_B_re'],
        prm['s5_B_im'], prm['s5_C_re'], prm['s5_C_im'], prm['s5_D'], prm['s5_w_glu'], prm['s5_b_glu'])
    y_h, hg_S_new = _hgrn2_mix(p_h, hg_S, lb, prm['hgrn_norm'])
    y_g, gl_S_new = _gla_mix(p_g, gl_S, prm['gla_gk_up'], prm['gla_gk_b'], prm['gla_norm'])
    mix = jnp.concatenate([y_r, y_s5, y_h, y_g], axis=-1) @ prm['w_out']
    x = x + mix.astype(x.dtype)
    y_f, ffn_buf_new = _conv_ffn(_rmsnorm(x, prm['norm_ffn']), ffn_buf, prm['ffn_w_up'],
                                 prm['ffn_conv_w'], prm['ffn_conv_b'], prm['ffn_w_down'])
    x = x + y_f
    return x, (rw_S_new, rw_shift_new, s5_re_new, s5_im_new, hg_S_new, gl_S_new, ffn_buf_new)


def setup_inputs(seed: int = 0) -> dict:
    key = jax.random.key(seed)
    keys = iter(jax.random.split(key, 64))
    f32 = jnp.float32
    L = DEPTH

    def nrm(shape, scale):
        return scale * jax.random.normal(next(keys), shape, f32)

    def unif(shape, lo, hi):
        return jax.random.uniform(next(keys), shape, f32, lo, hi)

    n_idx = jnp.arange(S5_STATE, dtype=f32)
    return {
        'x_prompt': nrm((BATCH, SEQ, D_MODEL), 1.0),
        'x_sample': nrm((DEC_BATCH, DEC_SEQ, D_MODEL), 1.0),
        'state_rwkv': nrm((L, DEC_BATCH, R_HEADS, R_HEAD_DIM, R_HEAD_DIM), 0.5),
        'state_rwkv_shift': nrm((L, DEC_BATCH, R_COLS), 1.0),
        'state_s5_re': nrm((L, DEC_BATCH, S5_GROUPS, S5_STATE), 0.5),
        'state_s5_im': nrm((L, DEC_BATCH, S5_GROUPS, S5_STATE), 0.5),
        'state_hgrn': nrm((L, DEC_BATCH, H_HEADS, H_HEAD_DIM, H_HEAD_DIM), 0.5),
        'state_gla': nrm((L, DEC_BATCH, G_HEADS, G_KEY_DIM, G_VAL_DIM), 0.5),
        'state_ffn_conv': nrm((L, DEC_BATCH, CONV_W - 1, D_FF), 1.0),
        'meta_tokens': nrm((N_META, D_MODEL), 1.0),
        'norm_mix': 1.0 + nrm((L, D_MODEL), 0.02),
        'w_in': nrm((L, D_MODEL, IN_COLS), D_MODEL ** -0.5),
        'w_out': nrm((L, MIX_WIDTH, D_MODEL), MIX_WIDTH ** -0.5),
        'rwkv_mu': unif((L, R_COLS), 0.0, 1.0),
        'rwkv_w0': nrm((L, R_WIDTH), 0.5),
        'rwkv_w_up': nrm((L, R_DECAY_RANK, R_WIDTH), 0.5 * R_DECAY_RANK ** -0.5),
        'rwkv_a0': nrm((L, R_WIDTH), 0.5),
        'rwkv_a_up': nrm((L, R_ICL_RANK, R_WIDTH), 0.5 * R_ICL_RANK ** -0.5),
        'rwkv_g_up': nrm((L, R_GATE_RANK, R_WIDTH), R_GATE_RANK ** -0.5),
        'rwkv_k_k': 0.85 + nrm((L, R_WIDTH), 0.05),
        'rwkv_k_a': 1.0 + nrm((L, R_WIDTH), 0.05),
        'rwkv_r_k': nrm((L, R_HEADS, R_HEAD_DIM), 0.1),
        'rwkv_ln': 1.0 + nrm((L, R_WIDTH), 0.02),
        's5_A_re': -0.5 + nrm((L, S5_GROUPS, S5_STATE), 0.01),
        's5_A_im': math.pi * n_idx + nrm((L, S5_GROUPS, S5_STATE), 0.01),
        's5_log_dt': unif((L, S5_GROUPS), math.log(0.001), math.log(0.1)),
        's5_B_re': nrm((L, S5_GROUPS, S5_STATE, S5_GROUP_CH), (2.0 * S5_GROUP_CH) ** -0.5),
        's5_B_im': nrm((L, S5_GROUPS, S5_STATE, S5_GROUP_CH), (2.0 * S5_GROUP_CH) ** -0.5),
        's5_C_re': nrm((L, S5_GROUPS, S5_GROUP_CH, S5_STATE), (2.0 * S5_STATE) ** -0.5),
        's5_C_im': nrm((L, S5_GROUPS, S5_GROUP_CH, S5_STATE), (2.0 * S5_STATE) ** -0.5),
        's5_D': nrm((L, S5_WIDTH), 1.0),
        's5_w_glu': nrm((L, S5_WIDTH, S5_WIDTH), S5_WIDTH ** -0.5),
        's5_b_glu': nrm((L, S5_WIDTH), 0.02),
        'hgrn_lower_bounds': nrm((L, H_WIDTH), 0.1),
        'hgrn_norm': 1.0 + nrm((L, H_WIDTH), 0.02),
        'gla_gk_up': nrm((L, G_GATE_RANK, G_QK), G_GATE_RANK ** -0.5),
        'gla_gk_b': nrm((L, G_QK), 0.1),
        'gla_norm': 1.0 + nrm((L, G_WIDTH), 0.02),
        'norm_ffn': 1.0 + nrm((L, D_MODEL), 0.02),
        'ffn_w_up': nrm((L, D_MODEL, 2 * D_FF), D_MODEL ** -0.5),
        'ffn_conv_w': nrm((L, CONV_W, D_FF), CONV_W ** -0.5),
        'ffn_conv_b': nrm((L, D_FF), 0.02),
        'ffn_w_down': nrm((L, D_FF, D_MODEL), D_FF ** -0.5),
        'norm_final': 1.0 + nrm((D_MODEL,), 0.02),
    }


def reference(x_prompt, x_sample, state_rwkv, state_rwkv_shift, state_s5_re, state_s5_im,
              state_hgrn, state_gla, state_ffn_conv, meta_tokens, norm_mix, w_in, w_out,
              rwkv_mu, rwkv_w0, rwkv_w_up, rwkv_a0, rwkv_a_up, rwkv_g_up, rwkv_k_k, rwkv_k_a,
              rwkv_r_k, rwkv_ln, s5_A_re, s5_A_im, s5_log_dt, s5_B_re, s5_B_im, s5_C_re, s5_C_im,
              s5_D, s5_w_glu, s5_b_glu, hgrn_lower_bounds, hgrn_norm, gla_gk_up, gla_gk_b,
              gla_norm, norm_ffn, ffn_w_up, ffn_conv_w, ffn_conv_b, ffn_w_down, norm_final):
    f32 = jnp.float32
    lb_soft = jax.nn.softmax(hgrn_lower_bounds.astype(f32), axis=0)
    lower_bound = jnp.cumsum(lb_soft, axis=0) - lb_soft[0]

    Bp = x_prompt.shape[0]
    dt = x_prompt.dtype
    meta = jnp.broadcast_to(meta_tokens.astype(dt)[None], (Bp, N_META, D_MODEL))
    xp = jnp.concatenate([meta, x_prompt], axis=1)
    xs = x_sample
    prompt_init = (
        jnp.zeros((Bp, R_HEADS, R_HEAD_DIM, R_HEAD_DIM), dt),
        jnp.zeros((Bp, R_COLS), dt),
        jnp.zeros((Bp, S5_GROUPS, S5_STATE), dt),
        jnp.zeros((Bp, S5_GROUPS, S5_STATE), dt),
        jnp.zeros((Bp, H_HEADS, H_HEAD_DIM, H_HEAD_DIM), dt),
        jnp.zeros((Bp, G_HEADS, G_KEY_DIM, G_VAL_DIM), dt),
        jnp.zeros((Bp, CONV_W - 1, D_FF), dt),
    )
    prompt_states = []
    sample_states = []
    for l in range(DEPTH):
        prm = {
            'norm_mix': norm_mix[l], 'w_in': w_in[l], 'w_out': w_out[l],
            'rwkv_mu': rwkv_mu[l], 'rwkv_w0': rwkv_w0[l], 'rwkv_w_up': rwkv_w_up[l],
            'rwkv_a0': rwkv_a0[l], 'rwkv_a_up': rwkv_a_up[l], 'rwkv_g_up': rwkv_g_up[l],
            'rwkv_k_k': rwkv_k_k[l], 'rwkv_k_a': rwkv_k_a[l], 'rwkv_r_k': rwkv_r_k[l],
            'rwkv_ln': rwkv_ln[l],
            's5_A_re': s5_A_re[l], 's5_A_im': s5_A_im[l], 's5_log_dt': s5_log_dt[l],
            's5_B_re': s5_B_re[l], 's5_B_im': s5_B_im[l], 's5_C_re': s5_C_re[l],
            's5_C_im': s5_C_im[l], 's5_D': s5_D[l], 's5_w_glu': s5_w_glu[l], 's5_b_glu': s5_b_glu[l],
            'hgrn_norm': hgrn_norm[l],
            'gla_gk_up': gla_gk_up[l], 'gla_gk_b': gla_gk_b[l], 'gla_norm': gla_norm[l],
            'norm_ffn': norm_ffn[l], 'ffn_w_up': ffn_w_up[l], 'ffn_conv_w': ffn_conv_w[l],
            'ffn_conv_b': ffn_conv_b[l], 'ffn_w_down': ffn_w_down[l],
        }
        xp, st_p = _layer(xp, prompt_init, prm, lower_bound[l])
        st_in = (state_rwkv[l], state_rwkv_shift[l], state_s5_re[l], state_s5_im[l],
                 state_hgrn[l], state_gla[l], state_ffn_conv[l])
        xs, st_s = _layer(xs, st_in, prm, lower_bound[l])
        prompt_states.append(st_p)
        sample_states.append(st_s)

    y_prompt = _rmsnorm(xp[:, N_META:], norm_final)
    y_sample = _rmsnorm(xs, norm_final)
    sp = [jnp.stack([st[i] for st in prompt_states]) for i in range(7)]
    ss = [jnp.stack([st[i] for st in sample_states]) for i in range(7)]
    return (y_prompt, y_sample, sp[0], ss[0], sp[1], ss[1], sp[2], ss[2], sp[3], ss[3],
            sp[4], ss[4], sp[5], ss[5], sp[6], ss[6])
```

```cpp
#include <hip/hip_runtime.h>
#include <cstdio>
#include <cstdint>
#define MK_PER_PHASE 0
#define PROBE_DUP 0
namespace pg8 {
__device__ __forceinline__ int lane_id() { unsigned m_ = ~0u; asm volatile("" : "+s"(m_)); return (int)__builtin_amdgcn_mbcnt_hi(m_, __builtin_amdgcn_mbcnt_lo(m_, 0u)); }
#define PG8_LAS __attribute__((address_space(3)))
typedef unsigned short bf16_t;
typedef short bf16x8 __attribute__((ext_vector_type(8)));
typedef float f32x4 __attribute__((ext_vector_type(4)));
typedef unsigned u32x4 __attribute__((ext_vector_type(4)));
constexpr int BM = 256, BK = 64, HALF = 128, HTB = HALF * BK * 2  , STAGE_BYTES = 8 * HTB, NXCD = 8, WGM = 8;

__host__ __device__ __forceinline__ int lds_byte(int r, int c) { const int st = (r >> 4) * 2 + (c >> 5), rr = r & 15, cc = c & 31, ob = rr * 64 + cc * 2; return st * 1024 + (ob ^ (((ob >> 9) & 1) << 5)); }
__host__ __device__ __forceinline__ void stage_rc(int b, int& R, int& C) { const int st = b / 1024, sb = b % 1024, swz = sb ^ (((sb >> 9) & 1) << 5); R = (st >> 1) * 16 + swz / 64; C = (st & 1) * 32 + (swz % 64) / 2; }
__host__ __device__ __forceinline__ int perm32(int rho) { const int n = rho >> 4, i = rho & 15; return 8 * (i >> 2) + 4 * n + (i & 3); }

struct Unit { int pm, pn, k0, nt, part; };
struct Gemm { const bf16_t* A; const bf16_t* Bt; int M, N, K; };

struct StaticOrder {
    int nM, nN, nwg, G, c;
    __host__ __device__ __forceinline__ void init(int M, int N, int G_, int c_) { nM = M / BM; nN = N / BM; nwg = nM * nN; G = G_; c = c_; }
    __host__ __device__ __forceinline__ bool next(int i, Unit& u) const {
        const long L = (long)i * G + c; if (L >= nwg) return false;
        int wgid = (int)L; { const int q = nwg / NXCD, r = nwg % NXCD, xcd = wgid % NXCD, off = wgid / NXCD; wgid = (xcd < r ? xcd * (q + 1) : r * (q + 1) + (xcd - r) * q) + off; }
        const int nig = WGM * nN, gid = wgid / nig, fm = gid * WGM, gsz = (nM - fm) < WGM ? (nM - fm) : WGM;
        u.pm = fm + ((wgid % nig) % gsz); u.pn = (wgid % nig) / gsz; u.k0 = 0; u.nt = 0; u.part = 0; return true;
    }
    __device__ __forceinline__ void a_ready(const Unit&) const {}
    __device__ __forceinline__ void done(const Unit&) const {}
};

struct SplitTailOrder : StaticOrder {
    int full, rem, P, np;
    __host__ __device__ __forceinline__ void init2(int M, int N, int K, int G_, int c_) { init(M, N, G_, c_); full = nwg / G; rem = nwg - full * G; np = K / (2 * BK); P = rem ? G / rem : 1; if (P > np / 2) P = np / 2; if (P < 1) P = 1; }
    __host__ __device__ __forceinline__ bool next(int i, Unit& u) const {
        if (i < full) return StaticOrder::next(i, u);
        if (i > full || rem == 0 || c >= rem * P) return false;
        const int ru = c % rem, p = c / rem;
        StaticOrder t = *this; t.c = ru; if (!t.StaticOrder::next(full, u)) return false;
        const int p0 = (p * np) / P, p1 = ((p + 1) * np) / P; u.k0 = 2 * p0; u.nt = 2 * (p1 - p0); u.part = ru * P + p; return true;
    }
};
typedef float f32x2c_ __attribute__((ext_vector_type(2)));
typedef __bf16 bf16x2c_ __attribute__((ext_vector_type(2)));
__device__ __forceinline__ unsigned cvt_pk_bf16(float lo, float hi) { const f32x2c_ v = {lo, hi}; const bf16x2c_ b = __builtin_convertvector(v, bf16x2c_); return __builtin_bit_cast(unsigned, b); }
typedef float f32x2 __attribute__((ext_vector_type(2)));
template <class Epi, class Sched, bool ALIGN_EPI = false, bool SP2 = false>
__device__ __forceinline__ void gemm_phase(PG8_LAS unsigned char* lds, const Gemm g, const Sched& S, const Epi& E, int wave_in) {
    int wv_ = wave_in; asm volatile("" : "+s"(wv_)); const int tid = wv_ * 64 + lane_id(), wid = __builtin_amdgcn_readfirstlane(tid >> 6), lane = tid & 63, wr = wid >> 2, wc = wid & 3, fr = lane & 15, fq = lane >> 4;
    const int K = g.K, ntK = K / BK;
    unsigned voffA[2], voffB[2];
#pragma unroll
    for (int i = 0; i < 2; ++i) { int R, C; stage_rc(tid * 16 + i * 8192, R, C); const int Rb = Epi::PERM ? ((R & ~31) + perm32(R & 31)) : R;
        voffA[i] = (unsigned)(R * K + C) * 2u; voffB[i] = (unsigned)(Rb * K + C) * 2u; }
    const size_t kstep = (size_t)(BK * 2);
    const size_t hstep = (size_t)HALF * K * 2;
    const size_t tstep = 2 * hstep;
    const unsigned ldsw = (unsigned)wid * 1024u;
    const int aoff = lds_byte(wr * 64 + fr, fq * 8), boff = lds_byte(wc * 32 + fr, fq * 8);
#define PG8_SA(b, h) (((b) * 2 + (h)) * HTB)
#define PG8_SB(b, h) ((4 + (b) * 2 + (h)) * HTB)
#define PG8_STAGE(bufoff, gbase, voff) do { _Pragma("unroll") for (int _i = 0; _i < 2; ++_i) \
        __builtin_amdgcn_global_load_lds((const unsigned*)((const char*)(gbase) + (voff)[_i]), (PG8_LAS unsigned*)(lds + (bufoff) + ldsw + _i * 8192), 16, 0, 0); } while (0)
#define PG8_LDA(dst, b, h) do { _Pragma("unroll") for (int m = 0; m < 4; ++m) _Pragma("unroll") for (int k = 0; k < 2; ++k) dst[m][k] = *(const PG8_LAS bf16x8*)(lds + PG8_SA(b, h) + aoff + m * 2048 + k * 1024); } while (0)
#define PG8_LDB(dst, b, h) do { _Pragma("unroll") for (int n = 0; n < 2; ++n) _Pragma("unroll") for (int k = 0; k < 2; ++k) dst[n][k] = *(const PG8_LAS bf16x8*)(lds + PG8_SB(b, h) + boff + n * 2048 + k * 1024); } while (0)
#define PG8_MMA(ai, bj, At, Bt) do { __builtin_amdgcn_s_setprio(1); _Pragma("unroll") for (int m = 0; m < 4; ++m) _Pragma("unroll") for (int n = 0; n < 2; ++n) _Pragma("unroll") for (int k = 0; k < 2; ++k) \
        acc[ai][bj][m][n] = __builtin_amdgcn_mfma_f32_16x16x32_bf16(Bt[n][k], At[m][k], acc[ai][bj][m][n], 0, 0, 0); __builtin_amdgcn_s_setprio(0); } while (0)
#define PG8_WAIT_V(n) asm volatile("s_waitcnt vmcnt(" #n ")" ::: "memory")
#define PG8_WAIT_L(n) asm volatile("s_waitcnt lgkmcnt(" #n ")" ::: "memory")
#define PG8_BAR __builtin_amdgcn_s_barrier()
#define PG8_SCHED __builtin_amdgcn_sched_barrier(0)
    Unit cur, nxt; int ui = 0;
    if (!S.next(0, cur)) return;
    if (cur.nt == 0) cur.nt = ntK;
    f32x4 acc[2][2][4][2];
#pragma unroll
    for (int a = 0; a < 2; ++a)
#pragma unroll
        for (int b = 0; b < 2; ++b)
#pragma unroll
            for (int m = 0; m < 4; ++m)
#pragma unroll
                for (int n = 0; n < 2; ++n) acc[a][b][m][n] = (f32x4){0.f, 0.f, 0.f, 0.f};
    bf16x8 At[4][2], B0[2][2], B1[2][2];
    const char* cA = (const char*)g.A + (size_t)cur.pm * tstep + (size_t)cur.k0 * kstep; const char* cB = (const char*)g.Bt + (size_t)cur.pn * tstep + (size_t)cur.k0 * kstep;
    S.a_ready(cur);
    if constexpr (SP2) {
        PG8_STAGE(PG8_SB(0, 0), cB, voffB); PG8_STAGE(PG8_SB(0, 1), cB + hstep, voffB); PG8_STAGE(PG8_SA(0, 0), cA, voffA); PG8_STAGE(PG8_SA(0, 1), cA + hstep, voffA);
        if (wr == 1) PG8_BAR;
        PG8_WAIT_V(2); PG8_BAR;
        PG8_STAGE(PG8_SB(1, 0), cB + kstep, voffB); PG8_STAGE(PG8_SA(1, 0), cA + kstep, voffA); PG8_STAGE(PG8_SB(1, 1), cB + hstep + kstep, voffB);
        PG8_WAIT_V(6); PG8_BAR;
    } else {
        PG8_STAGE(PG8_SB(0, 0), cB, voffB); PG8_STAGE(PG8_SA(0, 0), cA, voffA); PG8_STAGE(PG8_SB(0, 1), cB + hstep, voffB); PG8_STAGE(PG8_SA(0, 1), cA + hstep, voffA);
        if (wr == 1) PG8_BAR;
        PG8_WAIT_V(4); PG8_BAR;
        PG8_STAGE(PG8_SB(1, 0), cB + kstep, voffB); PG8_STAGE(PG8_SA(1, 0), cA + kstep, voffA); PG8_STAGE(PG8_SB(1, 1), cB + hstep + kstep, voffB);
        PG8_WAIT_V(6); PG8_BAR;
    }
    for (;;) {
        const bool has_next = S.next(ui + 1, nxt);
        if (has_next && nxt.nt == 0) nxt.nt = ntK;
        const int nt = cur.nt;
        const char* nA = has_next ? (const char*)g.A + (size_t)nxt.pm * tstep + (size_t)nxt.k0 * kstep : cA; const char* nB = has_next ? (const char*)g.Bt + (size_t)nxt.pn * tstep + (size_t)nxt.k0 * kstep : cB;
        for (int t = 0; t < nt; t += 2) {
            const bool last = (t == nt - 2);
            const char* a1 = cA + (size_t)(t + 1) * kstep;
            const char* a2 = last ? nA : cA + (size_t)(t + 2) * kstep; const char* b2 = last ? nB : cB + (size_t)(t + 2) * kstep;
            const char* a3 = a2 + kstep; const char* b3 = b2 + kstep;
            if (last && has_next) S.a_ready(nxt);
            if constexpr (SP2) {
            PG8_LDB(B0, 0, 0); PG8_LDB(B1, 0, 1); PG8_SCHED; PG8_LDA(At, 0, 0); PG8_STAGE(PG8_SA(1, 1), a1 + hstep, voffA);
            PG8_WAIT_V(8); PG8_WAIT_L(0); PG8_BAR; PG8_MMA(0, 0, At, B0); PG8_MMA(0, 1, At, B1); PG8_BAR; PG8_SCHED;
            PG8_LDA(At, 0, 1); PG8_STAGE(PG8_SB(0, 0), b2, voffB); PG8_STAGE(PG8_SB(0, 1), b2 + hstep, voffB); PG8_STAGE(PG8_SA(0, 0), a2, voffA);
            PG8_WAIT_V(8); PG8_WAIT_L(0); PG8_BAR; PG8_MMA(1, 0, At, B0); PG8_MMA(1, 1, At, B1); PG8_BAR; PG8_SCHED;
            PG8_LDB(B0, 1, 0); PG8_LDB(B1, 1, 1); PG8_SCHED; PG8_LDA(At, 1, 0); PG8_STAGE(PG8_SA(0, 1), a2 + hstep, voffA);
            PG8_WAIT_V(8); PG8_WAIT_L(0); PG8_BAR; PG8_MMA(0, 0, At, B0); PG8_MMA(0, 1, At, B1); PG8_BAR; PG8_SCHED;
            PG8_LDA(At, 1, 1); PG8_STAGE(PG8_SB(1, 0), b3, voffB); PG8_STAGE(PG8_SB(1, 1), b3 + hstep, voffB); PG8_STAGE(PG8_SA(1, 0), a3, voffA);
            PG8_WAIT_V(8); PG8_WAIT_L(0); PG8_BAR; PG8_MMA(1, 0, At, B0); PG8_MMA(1, 1, At, B1); PG8_BAR; PG8_SCHED;
            } else {
            PG8_LDB(B0, 0, 0); PG8_SCHED; PG8_LDA(At, 0, 0); PG8_STAGE(PG8_SA(1, 1), a1 + hstep, voffA);
            PG8_WAIT_L(8); PG8_BAR; PG8_WAIT_L(0); PG8_MMA(0, 0, At, B0); PG8_BAR; PG8_SCHED;
            PG8_LDB(B1, 0, 1); PG8_STAGE(PG8_SB(0, 0), b2, voffB);
            PG8_BAR; PG8_WAIT_L(0); PG8_MMA(0, 1, At, B1); PG8_BAR;
            PG8_LDA(At, 0, 1); PG8_STAGE(PG8_SA(0, 0), a2, voffA);
            PG8_BAR; PG8_WAIT_L(0); PG8_MMA(1, 0, At, B0); PG8_BAR; PG8_SCHED;
            PG8_STAGE(PG8_SB(0, 1), b2 + hstep, voffB);
            PG8_WAIT_V(6); PG8_BAR; PG8_MMA(1, 1, At, B1); PG8_BAR;
            PG8_LDB(B0, 1, 0); PG8_SCHED; PG8_LDA(At, 1, 0); PG8_STAGE(PG8_SA(0, 1), a2 + hstep, voffA);
            PG8_WAIT_L(8); PG8_BAR; PG8_WAIT_L(0); PG8_MMA(0, 0, At, B0); PG8_BAR; PG8_SCHED;
            PG8_LDB(B1, 1, 1); PG8_STAGE(PG8_SB(1, 0), b3, voffB);
            PG8_BAR; PG8_WAIT_L(0); PG8_MMA(0, 1, At, B1); PG8_BAR;
            PG8_LDA(At, 1, 1); PG8_STAGE(PG8_SA(1, 0), a3, voffA);
            PG8_BAR; PG8_WAIT_L(0); PG8_MMA(1, 0, At, B0); PG8_BAR; PG8_SCHED;
            PG8_STAGE(PG8_SB(1, 1), b3 + hstep, voffB);
            PG8_WAIT_V(6); PG8_BAR; PG8_MMA(1, 1, At, B1); PG8_BAR;
            }
        }
        if constexpr (ALIGN_EPI) { if (wr == 0) PG8_BAR; }
        if constexpr (!Epi::AFTER_DRAIN) { E(acc, cur, wr, wc, fr, fq); S.done(cur); }
        if (!has_next) break;
#pragma unroll
        for (int a = 0; a < 2; ++a)
#pragma unroll
            for (int b = 0; b < 2; ++b)
#pragma unroll
                for (int m = 0; m < 4; ++m)
#pragma unroll
                    for (int n = 0; n < 2; ++n) acc[a][b][m][n] = (f32x4){0.f, 0.f, 0.f, 0.f};
        cur = nxt; cA = nA; cB = nB; ++ui;
        if constexpr (ALIGN_EPI) { if (wr == 1) PG8_BAR; }
    }
    PG8_WAIT_V(0);
    if constexpr (!ALIGN_EPI) { if (wr == 0) PG8_BAR; }
    PG8_BAR;
    if constexpr (Epi::AFTER_DRAIN) { E.fused(acc, cur, wr, wc, fr, fq, lds, wid, lane); S.done(cur); }
#undef PG8_SA
#undef PG8_SB
#undef PG8_STAGE
#undef PG8_LDA
#undef PG8_LDB
#undef PG8_MMA
#undef PG8_WAIT_V
#undef PG8_WAIT_L
#undef PG8_BAR
#undef PG8_SCHED
}
}
namespace pg8 {
struct EpiStoreBf16 {
    static constexpr bool PERM = true, AFTER_DRAIN = false;
    bf16_t* O; int ldc;
    __device__ __forceinline__ void operator()(const f32x4 (&acc)[2][2][4][2], const Unit& u, int wr, int wc, int fr, int fq) const {
        const int row0 = u.pm * BM + wr * 64 + fr, col0 = u.pn * BM + wc * 32 + 8 * fq;
#pragma unroll
        for (int ai = 0; ai < 2; ++ai)
#pragma unroll
            for (int m = 0; m < 4; ++m) { bf16_t* rowp = O + (size_t)(row0 + ai * HALF + m * 16) * ldc + col0;
#pragma unroll
                for (int bj = 0; bj < 2; ++bj) { const f32x4 v0 = acc[ai][bj][m][0], v1 = acc[ai][bj][m][1];
                    u32x4 w; w.x = cvt_pk_bf16(v0[0], v0[1]); w.y = cvt_pk_bf16(v0[2], v0[3]); w.z = cvt_pk_bf16(v1[0], v1[1]); w.w = cvt_pk_bf16(v1[2], v1[3]);
                    *(u32x4*)(rowp + bj * HALF) = w; } }
    }
};
template <bool SSQ_>
struct EpiResid {
    static constexpr bool PERM = true, AFTER_DRAIN = false;
    bf16_t* X; int ldc; int ntK; float* slab; float* ssq;
    __device__ __forceinline__ void operator()(const f32x4 (&acc)[2][2][4][2], const Unit& u, int wr, int wc, int fr, int fq) const {
        const int row0 = u.pm * BM + wr * 64 + fr, col0 = u.pn * BM + wc * 32 + 8 * fq;
        if (!SSQ_ && u.nt != ntK) {
            bf16_t* sl = (bf16_t*)slab + (size_t)u.part * (BM * BM) + (size_t)(wr * 64 + fr) * BM + wc * 32 + 8 * fq;
#pragma unroll
            for (int ai = 0; ai < 2; ++ai)
#pragma unroll
                for (int m = 0; m < 4; ++m)
#pragma unroll
                    for (int bj = 0; bj < 2; ++bj) { const f32x4 v0 = acc[ai][bj][m][0], v1 = acc[ai][bj][m][1];
                        u32x4 w; w.x = cvt_pk_bf16(v0[0], v0[1]); w.y = cvt_pk_bf16(v0[2], v0[3]); w.z = cvt_pk_bf16(v1[0], v1[1]); w.w = cvt_pk_bf16(v1[2], v1[3]);
                        *(u32x4*)(sl + (size_t)(ai * HALF + m * 16) * BM + bj * HALF) = w; }
            return;
        }
#pragma unroll
        for (int ai = 0; ai < 2; ++ai) {
            u32x4 old[4][2];
#pragma unroll
            for (int m = 0; m < 4; ++m)
#pragma unroll
                for (int bj = 0; bj < 2; ++bj) old[m][bj] = *(const u32x4*)(X + (size_t)(row0 + ai * HALF + m * 16) * ldc + col0 + bj * HALF);
#pragma unroll
            for (int m = 0; m < 4; ++m) { const int row = row0 + ai * HALF + m * 16; bf16_t* rowp = X + (size_t)row * ldc + col0;
                float sq = 0.f;
#pragma unroll
                for (int bj = 0; bj < 2; ++bj) { const f32x4 v0 = acc[ai][bj][m][0], v1 = acc[ai][bj][m][1]; const u32x4 o = old[m][bj];
                    float t[8];
                    t[0] = __builtin_bit_cast(float, o.x << 16) + v0[0]; t[1] = __builtin_bit_cast(float, o.x & 0xffff0000u) + v0[1];
                    t[2] = __builtin_bit_cast(float, o.y << 16) + v0[2]; t[3] = __builtin_bit_cast(float, o.y & 0xffff0000u) + v0[3];
                    t[4] = __builtin_bit_cast(float, o.z << 16) + v1[0]; t[5] = __builtin_bit_cast(float, o.z & 0xffff0000u) + v1[1];
                    t[6] = __builtin_bit_cast(float, o.w << 16) + v1[2]; t[7] = __builtin_bit_cast(float, o.w & 0xffff0000u) + v1[3];
                    u32x4 w; w.x = cvt_pk_bf16(t[0], t[1]); w.y = cvt_pk_bf16(t[2], t[3]); w.z = cvt_pk_bf16(t[4], t[5]); w.w = cvt_pk_bf16(t[6], t[7]);
                    *(u32x4*)(rowp + bj * HALF) = w;
                    if (SSQ_) {
#pragma unroll
                        for (int j = 0; j < 8; ++j) sq += t[j] * t[j]; } }
                if (SSQ_) { sq += __shfl_xor(sq, 16); sq += __shfl_xor(sq, 32); if (fq == 0) ssq[(size_t)row * 32 + u.pn * 4 + wc] = sq; } }
        }
    }
};
}
namespace pg8 {
struct EpiGlu {
    static constexpr bool PERM = true, AFTER_DRAIN = false;
    bf16_t* O; int ldc; const bf16_t* Y; int ldy; const float* bias;
    __device__ __forceinline__ void operator()(const f32x4 (&acc)[2][2][4][2], const Unit& u, int wr, int wc, int fr, int fq) const {
        const int row0 = u.pm * BM + wr * 64 + fr, col0 = u.pn * BM + wc * 32 + 8 * fq;
#pragma unroll
        for (int bj = 0; bj < 2; ++bj) { const f32x4 b0 = *(const f32x4*)(bias + col0 + bj * HALF), b1 = *(const f32x4*)(bias + col0 + bj * HALF + 4);
            u32x4 yv[2][4];
#pragma unroll
            for (int ai = 0; ai < 2; ++ai)
#pragma unroll
                for (int m = 0; m < 4; ++m) yv[ai][m] = *(const u32x4*)(Y + (size_t)(row0 + ai * HALF + m * 16) * ldy + col0 + bj * HALF);
#pragma unroll
            for (int ai = 0; ai < 2; ++ai)
#pragma unroll
                for (int m = 0; m < 4; ++m) { const size_t row = (size_t)(row0 + ai * HALF + m * 16);
                    const u32x4 yw = yv[ai][m];
                    const f32x4 v0 = acc[ai][bj][m][0] + b0, v1 = acc[ai][bj][m][1] + b1;
                    float y[8];
#pragma unroll
                    for (int j = 0; j < 4; ++j) { y[2 * j] = __builtin_bit_cast(float, yw[j] << 16); y[2 * j + 1] = __builtin_bit_cast(float, yw[j] & 0xffff0000u); }
                    float o[8];
#pragma unroll
                    for (int j = 0; j < 4; ++j) { o[j] = y[j] * __builtin_amdgcn_rcpf(1.f + __expf(-v0[j])); o[4 + j] = y[4 + j] * __builtin_amdgcn_rcpf(1.f + __expf(-v1[j])); }
                    u32x4 w; w.x = cvt_pk_bf16(o[0], o[1]); w.y = cvt_pk_bf16(o[2], o[3]); w.z = cvt_pk_bf16(o[4], o[5]); w.w = cvt_pk_bf16(o[6], o[7]);
                    *(u32x4*)(O + row * ldc + col0 + bj * HALF) = w; } }
    }
};
}
#ifndef PROBE_DUP
#define PROBE_DUP 0
#endif
#define DUPN(k) (((PROBE_DUP) >> (k)) & 1 ? 2 : 1)
#ifndef MK_PER_PHASE
#define MK_PER_PHASE 0
#endif
constexpr int D = 2048, NB = 4, SEQ = 2048, NL = 4, NS = 128, TS = 4, NMETA = 16;
constexpr int TP = SEQ + NMETA, MP = NB * TP, MS = NS * TS, M = MP + MS, MPAD = 8960, NSEQ = NB + NS;
constexpr int RC = 1792, SC = 512, HC = 2048, GC = 1552, INC = RC + SC + HC + GC, INP = 6144;
constexpr int OFF_R = 0, OFF_S = RC, OFF_H = RC + SC, OFF_G = RC + SC + HC;
constexpr int FF = 5504, FF2 = 2 * FF;
constexpr float EPS = 1e-6f;
static_assert(INC == 5904 && MPAD % 256 == 0 && MPAD >= M && INP % 256 == 0 && FF2 % 256 == 0 && FF % 128 == 0, "shapes");
constexpr int NWAVES = 8, NTHR = 512;
constexpr int MA_IN = 8192, NB_IN = ((MPAD - MA_IN) / 256) * (INP / 256), NB_OUTB = ((MPAD - MA_IN) / 256) * (D / 256), UP1_ROUNDS = 5;
constexpr int RW_ITEMS = NB * 8 * 65, RW_XWG = 4;
constexpr size_t O_YP = 0;
constexpr size_t O_YS = O_YP + (size_t)NB * SEQ * D;
constexpr size_t O_RWP = O_YS + (size_t)NS * TS * D;
constexpr size_t O_RWS = O_RWP + (size_t)NL * NB * 8 * 64 * 64;
constexpr size_t O_SHP = O_RWS + (size_t)NL * NS * 8 * 64 * 64;
constexpr size_t O_SHS = O_SHP + (size_t)NL * NB * RC;
constexpr size_t O_SRP = O_SHS + (size_t)NL * NS * RC;
constexpr size_t O_SRS = O_SRP + (size_t)NL * NB * 2048;
constexpr size_t O_SIP = O_SRS + (size_t)NL * NS * 2048;
constexpr size_t O_SIS = O_SIP + (size_t)NL * NB * 2048;
constexpr size_t O_HGP = O_SIS + (size_t)NL * NS * 2048;
constexpr size_t O_HGS = O_HGP + (size_t)NL * NB * 4 * 128 * 128;
constexpr size_t O_GLP = O_HGS + (size_t)NL * NS * 4 * 128 * 128;
constexpr size_t O_GLS = O_GLP + (size_t)NL * NB * 4 * 64 * 128;
constexpr size_t O_CVP = O_GLS + (size_t)NL * NS * 4 * 64 * 128;
constexpr size_t O_CVS = O_CVP + (size_t)NL * NB * 2 * FF;
constexpr size_t O_END = O_CVS + (size_t)NL * NS * 2 * FF;
constexpr size_t al256(size_t x) { return (x + 255) & ~(size_t)255; }
constexpr size_t WS_CTL = 0, CTL_ZERO_BYTES = 1u << 20;
constexpr size_t WS_WIN = CTL_ZERO_BYTES;
constexpr size_t WS_WOUT = WS_WIN + (size_t)NL * INP * D * 2;
constexpr size_t WS_WUP = WS_WOUT + (size_t)NL * D * D * 2;
constexpr size_t WS_WDN = WS_WUP + (size_t)NL * FF2 * D * 2;
constexpr size_t WS_X = WS_WDN + (size_t)NL * D * FF * 2;
constexpr size_t WS_XN = WS_X + (size_t)MPAD * D * 4;
constexpr size_t WS_P = WS_XN + (size_t)MPAD * D * 2;
constexpr size_t WS_MIX = WS_P + (size_t)MPAD * INP * 2;
constexpr size_t WS_SMALL = WS_MIX + (size_t)MPAD * D * 2;
constexpr size_t WS_AB = WS_SMALL, WS_BB = WS_AB + (size_t)NL * 4096 * 4, WS_LB = WS_BB + (size_t)NL * 65536 * 4;
constexpr size_t WS_Y5 = al256(WS_LB + (size_t)NL * 512 * 4);
constexpr size_t WS_HQ = WS_Y5 + (size_t)MPAD * 512 * 2, WS_HK = WS_HQ + (size_t)M * 512 * 4;
constexpr size_t WS_GQ = WS_HK + (size_t)M * 512 * 4, WS_GD = WS_GQ + (size_t)M * 256 * 4;
constexpr size_t WS_OH = WS_GD + (size_t)M * 256 * 4, WS_OG = WS_OH + (size_t)M * 512 * 4;
constexpr size_t WS_OH1 = WS_OG + (size_t)M * 512 * 4;
constexpr size_t WS_GU = WS_OH1 + (size_t)M * 512 * 4;
constexpr size_t WS_GV = WS_GU + (size_t)48 * 65 * 12288;
constexpr size_t WS_WUPT = WS_GV + (size_t)4 * 8 * 65 * 4 * 2048;
constexpr size_t WS_AUPT = WS_WUPT + (size_t)NL * 512 * 64 * 2, WS_GUPT = WS_AUPT + (size_t)NL * 512 * 64 * 2;
constexpr size_t WS_RG = WS_GUPT + (size_t)NL * 512 * 128 * 2;
constexpr size_t WS_RBV = WS_RG + (size_t)M * 512 * 2;
constexpr size_t WS_RY = WS_RBV + (size_t)M * 512 * 4;
constexpr size_t WS_RU = WS_RY + (size_t)M * 512 * 4;
constexpr size_t WS_RV = WS_RU + (size_t)32 * 65 * 20480;
constexpr size_t WS_E5 = WS_RV + (size_t)4 * 8 * 65 * 2 * 2048;
constexpr size_t WS_T5 = WS_E5 + (size_t)NL * 32 * 32768 * 2, WS_G5 = WS_T5 + (size_t)NL * 32 * 65536 * 2, WS_A16 = WS_G5 + (size_t)NL * 32 * 32768 * 2;
constexpr size_t WS_ES = WS_A16 + (size_t)NL * 32 * 128 * 4;
constexpr size_t WS_XS = WS_ES + (size_t)4 * 32 * 160 * 128 * 4;
constexpr size_t WS_WGLUT = WS_XS + (size_t)4 * 32 * 160 * 128 * 2;
constexpr size_t WS_OVL = WS_WGLUT + (size_t)NL * 512 * 512 * 2;
constexpr size_t WS_U = WS_OVL, WS_ACT = WS_U + (size_t)MPAD * FF2 * 2;
constexpr size_t WS_RW = WS_OVL, WS_HS = WS_RW + (size_t)7 * M * 512 * 4;
constexpr size_t WS_END_A = WS_ACT + (size_t)MPAD * FF * 2, WS_END_B = WS_HS + (size_t)2 * M * 2048 * 4;
constexpr size_t WS_RSCR = WS_END_A > WS_END_B ? WS_END_A : WS_END_B;
constexpr size_t WS_SLAB = WS_RSCR + (size_t)2048 * 20480;
constexpr size_t WS_XDUMMY = WS_SLAB + (size_t)256 * 65536 * 4;
constexpr size_t WS_SSQ = WS_XDUMMY + (PROBE_DUP ? (size_t)MPAD * D * 4 : 0);
constexpr size_t WS_SINK = WS_SSQ + (size_t)MPAD * 32 * 4;
constexpr size_t WS_UT = WS_SINK + 4096;
constexpr size_t WS_END = WS_UT + (size_t)NB * 32 * 5 * 16 * 1024;
constexpr int CW_BAR = 4096;
constexpr int RING_OFF = 0, RING_BYTES = 131072;
constexpr int LDSCTL_OFF = RING_BYTES, MISC_OFF = LDSCTL_OFF + 320;
constexpr int LDS_BYTES = 147456;
#define GAS __attribute__((address_space(1)))
#define LAS __attribute__((address_space(3)))
typedef unsigned short bf16;
typedef unsigned v4u __attribute__((ext_vector_type(4)));
typedef unsigned v2u __attribute__((ext_vector_type(2)));
typedef float f32x4 __attribute__((ext_vector_type(4)));
typedef short bf16x8 __attribute__((ext_vector_type(8)));
typedef float f32x16 __attribute__((ext_vector_type(16)));
#define MF32(a, b, c) __builtin_amdgcn_mfma_f32_32x32x16_bf16(a, b, c, 0, 0, 0)
#define LDS_WAIT() asm volatile("s_waitcnt lgkmcnt(0)" ::: "memory")
#define VM_WAIT() asm volatile("s_waitcnt vmcnt(0)" ::: "memory")
__device__ __forceinline__ unsigned f2bf(float f) { unsigned u = __builtin_bit_cast(unsigned, f); return (u + 0x7fffu + ((u >> 16) & 1u)) >> 16; }
__device__ __forceinline__ unsigned pk2(float lo, float hi) { return f2bf(lo) | (f2bf(hi) << 16); }
__device__ __forceinline__ float bf2f(unsigned short b) { return __builtin_bit_cast(float, (unsigned)b << 16); }
__device__ __forceinline__ float bflo(unsigned w) { return __builtin_bit_cast(float, w << 16); }
__device__ __forceinline__ float bfhi(unsigned w) { return __builtin_bit_cast(float, w & 0xffff0000u); }
__device__ __forceinline__ float sigmoidf_(float x) { return 1.f / (1.f + expf(-x)); }
__device__ __forceinline__ float siluf_(float x) { return x * sigmoidf_(x); }
__device__ __forceinline__ float gelu_tanh(float x) { return 0.5f * x * (1.f + tanhf(0.7978845608028654f * (x + 0.044715f * x * x * x))); }
__device__ __forceinline__ float log_sigmoidf_(float x) { return fminf(x, 0.f) - log1pf(expf(-fabsf(x))); }
__device__ __forceinline__ float wave_sum(float v) {
#pragma unroll
    for (int o = 1; o < 64; o <<= 1) v += __shfl_xor(v, o);
    return v;
}
__device__ __forceinline__ void row_seq(int row, int& s, int& t) { if (row < MP) { s = row / TP; t = row % TP; } else { const int r = row - MP; s = NB + r / TS; t = r % TS; } }
__device__ __forceinline__ void seq_rows(int s, int& row0, int& T) { if (s < NB) { row0 = s * TP; T = TP; } else { row0 = MP + (s - NB) * TS; T = TS; } }
namespace pg8 {
__device__ __forceinline__ float gelu_fast2(float x) { const float u = -1.5957691216057308f * (x + 0.044715f * x * x * x); return x * __builtin_amdgcn_rcpf(1.f + __expf(u)); }
template <int CTRL> __device__ __forceinline__ float dpp_f(float x) { return __builtin_bit_cast(float, __builtin_amdgcn_update_dpp(0, __builtin_bit_cast(int, x), CTRL, 0xF, 0xF, true)); }
struct EpiConvAct {
    static constexpr bool PERM = true, AFTER_DRAIN = false;
    bf16_t* ACT; bf16_t* U; const float* cw; const float* cb; float* cvp; const float* ssq;
    __device__ __forceinline__ void operator()(const f32x4 (&acc)[2][2][4][2], const Unit& u, int wr, int wc, int fr, int fq) const {
        const int lane = lane_id();
        const int ffc = u.pn * 128 + wc * 32 + 8 * fq;
        float w0[8], w1[8], w2[8], bb[8];
#pragma unroll
        for (int j = 0; j < 8; j += 4) { const f32x4 a = *(const f32x4*)(cw + ffc + j), b2 = *(const f32x4*)(cw + FF + ffc + j), c = *(const f32x4*)(cw + 2 * FF + ffc + j), d = *(const f32x4*)(cb + ffc + j);
#pragma unroll
            for (int q = 0; q < 4; ++q) { w0[j + q] = a[q]; w1[j + q] = b2[q]; w2[j + q] = c[q]; bb[j + q] = d[q]; } }
        float rsv[2][4];
#pragma unroll
        for (int ai = 0; ai < 2; ++ai)
#pragma unroll
            for (int m = 0; m < 4; ++m) { const int row = u.pm * BM + ai * HALF + wr * 64 + m * 16 + fr; const f32x4* sp = (const f32x4*)(ssq + (size_t)row * 32 + fq * 8); const f32x4 a = sp[0], b2 = sp[1];
                float sq = ((a.x + a.y) + (a.z + a.w)) + ((b2.x + b2.y) + (b2.z + b2.w)); sq += __shfl_xor(sq, 16); sq += __shfl_xor(sq, 32); rsv[ai][m] = rsqrtf(sq * (1.f / D) + EPS); }
#pragma unroll
        for (int ai = 0; ai < 2; ++ai)
#pragma unroll
            for (int m = 0; m < 4; ++m) {
                const int row = u.pm * BM + ai * HALF + wr * 64 + m * 16 + fr;
                float o[8], u0[8], gt[8];
#pragma unroll
                for (int j = 0; j < 8; ++j) {
                    u0[j] = acc[ai][0][m][j >> 2][j & 3] * rsv[ai][m]; gt[j] = acc[ai][1][m][j >> 2][j & 3] * rsv[ai][m];
                    const float p1 = dpp_f<0x111>(u0[j]), p2 = dpp_f<0x112>(u0[j]);
                    float q1 = 0.f, q2 = 0.f;
                    if (m > 0) { const float up = acc[ai][0][m > 0 ? m - 1 : 0][j >> 2][j & 3] * rsv[ai][m > 0 ? m - 1 : 0]; q1 = dpp_f<0x121>(up); q2 = dpp_f<0x122>(up); }
                    const float v1 = fr == 0 ? q1 : p1, v2 = fr < 2 ? q2 : p2;
                    o[j] = gelu_fast2(bb[j] + w0[j] * v2 + w1[j] * v1 + w2[j] * u0[j]) * gt[j];
                }
                u32x4 w; w.x = cvt_pk_bf16(o[0], o[1]); w.y = cvt_pk_bf16(o[2], o[3]); w.z = cvt_pk_bf16(o[4], o[5]); w.w = cvt_pk_bf16(o[6], o[7]);
                *(u32x4*)(ACT + (size_t)row * FF + ffc) = w;
                const int r63 = row & 63; const int t = row < MP ? row % TP : 0;
                if (r63 < 2 || r63 >= 62 || row >= MP - 2 || (row < MP && t < 2)) {
                    u32x4 x; x.x = cvt_pk_bf16(u0[0], u0[1]); x.y = cvt_pk_bf16(u0[2], u0[3]); x.z = cvt_pk_bf16(u0[4], u0[5]); x.w = cvt_pk_bf16(u0[6], u0[7]);
                    u32x4 y; y.x = cvt_pk_bf16(gt[0], gt[1]); y.y = cvt_pk_bf16(gt[2], gt[3]); y.z = cvt_pk_bf16(gt[4], gt[5]); y.w = cvt_pk_bf16(gt[6], gt[7]);
                    *(u32x4*)(U + (size_t)row * FF2 + ffc) = x; *(u32x4*)(U + (size_t)row * FF2 + FF + ffc) = y;
                }
                if (row < MP && t >= TP - 2) { float* bo = cvp + ((size_t)(row / TP) * 2 + (t - (TP - 2))) * FF + ffc;
                    *(f32x4*)bo = (f32x4){u0[0], u0[1], u0[2], u0[3]}; *(f32x4*)(bo + 4) = (f32x4){u0[4], u0[5], u0[6], u0[7]}; }
            }
    }
};
struct ChainOrder {
    StaticOrder s; int mode, c, R, skipc, skipr, vg;
    __device__ __forceinline__ void init(int N_, int G_, int c_, int mode_, int R_, int skipc_, int skipr_, int vg_) { s.init(MA_IN, N_, G_, c_); mode = mode_; c = c_; R = R_; skipc = skipc_; skipr = skipr_; vg = vg_; }
    __device__ __forceinline__ bool unitL(int L, Unit& u) const { StaticOrder t = s; t.c = 0; t.G = 1; if (!t.next(L, u)) return false;
        if (vg) { const int p = u.pn; u.pn = p < 4 ? (p < 2 ? p + 10 : p + 20) : (p == 10 || p == 11) ? p - 10 : (p == 22 || p == 23) ? p - 20 : p; } return true; }
    __device__ __forceinline__ bool next(int i, Unit& u) const {
        constexpr int TR = (MPAD - MA_IN) / 256;
        if (vg) {
            const int Gv = s.G - skipc, nL1 = R * Gv < s.nwg ? R * Gv : s.nwg;
            if (mode == 0) { if (c < skipc || i >= R) return false; const int L = i * Gv + (c - skipc); return L < nL1 && unitL(L, u); }
            int q = i * s.G + c; const int n1 = s.nwg - nL1, nT = TR * s.nN;
            if (q < n1) return unitL(nL1 + q, u);
            q -= n1; if (q >= nT) return false;
            u.pm = MA_IN / 256 + q % TR; u.pn = q / TR; u.k0 = 0; u.nt = 0; u.part = 0; return true;
        }
        if (mode == 0) { const int i2 = i + (c < skipc ? skipr : 0); return i2 < R && s.next(i2, u); }
        const int n1 = s.nwg - R * s.G > 0 ? s.nwg - R * s.G : 0, nS = skipc * skipr, nT = TR * s.nN;
        int q = i * s.G + c;
        if (q < n1) { StaticOrder t = s; t.c = 0; t.G = 1; return t.next(R * s.G + q, u); }
        q -= n1;
        if (q < nS) { StaticOrder t = s; t.c = q % skipc; return t.next(q / skipc, u); }
        q -= nS;
        if (q >= nT) return false;
        u.pm = MA_IN / 256 + q % TR; u.pn = q / TR; u.k0 = 0; u.nt = 0; u.part = 0; return true;
    }
    __device__ __forceinline__ void a_ready(const Unit&) const {}
    __device__ __forceinline__ void done(const Unit&) const {}
};
struct EpiStoreBf16S {
    static constexpr bool PERM = true, AFTER_DRAIN = false;
    bf16_t* O; int ldc; const float* ssq;
    __device__ __forceinline__ void operator()(const f32x4 (&acc)[2][2][4][2], const Unit& u, int wr, int wc, int fr, int fq) const {
        const int row0 = u.pm * BM + wr * 64 + fr, col0 = u.pn * BM + wc * 32 + 8 * fq;
        f32x4 pa[2][4], pb[2][4];
#pragma unroll
        for (int ai = 0; ai < 2; ++ai)
#pragma unroll
            for (int m = 0; m < 4; ++m) { const f32x4* sp = (const f32x4*)(ssq + (size_t)(row0 + ai * HALF + m * 16) * 32 + fq * 8); pa[ai][m] = sp[0]; pb[ai][m] = sp[1]; }
#pragma unroll
        for (int ai = 0; ai < 2; ++ai)
#pragma unroll
            for (int m = 0; m < 4; ++m) { const int row = row0 + ai * HALF + m * 16; bf16_t* rowp = O + (size_t)row * ldc + col0; const f32x4 a = pa[ai][m], b2 = pb[ai][m];
                float sq = ((a.x + a.y) + (a.z + a.w)) + ((b2.x + b2.y) + (b2.z + b2.w)); sq += __shfl_xor(sq, 16); sq += __shfl_xor(sq, 32); const float rs = rsqrtf(sq * (1.f / D) + EPS);
#pragma unroll
                for (int bj = 0; bj < 2; ++bj) { const f32x4 v0 = acc[ai][bj][m][0] * rs, v1 = acc[ai][bj][m][1] * rs;
                    u32x4 w; w.x = cvt_pk_bf16(v0[0], v0[1]); w.y = cvt_pk_bf16(v0[2], v0[3]); w.z = cvt_pk_bf16(v1[0], v1[1]); w.w = cvt_pk_bf16(v1[2], v1[3]);
                    *(u32x4*)(rowp + bj * HALF) = w; } }
    }
};
}
#define XB_TMO      128
#define XB_XCNT(j)  (256  + 64 * (j))
#define XB_XSUB(j)  (1280 + 64 * (j))
#define XB_XGEN(j)  (2304 + 64 * (j))
#define XB_TOP      3328
#define XB_TOPGEN   3392
#define XCD_BAR_WORDS 3456
#define XB_SPIN_CAP (1u << 18)

__device__ __forceinline__ unsigned xb_ld(unsigned* p)              { return __hip_atomic_load(p, __ATOMIC_RELAXED, __HIP_MEMORY_SCOPE_AGENT); }
__device__ __forceinline__ unsigned xb_add(unsigned* p, unsigned v) { return __hip_atomic_fetch_add(p, v, __ATOMIC_RELAXED, __HIP_MEMORY_SCOPE_AGENT); }
__device__ __forceinline__ unsigned xb_xcc_id() { return (unsigned)__builtin_amdgcn_s_getreg((3 << 11) | 20) & 0xFu; }
#define XB_SPIN(cond, bar) do { unsigned _sp = 0; while (cond) { __builtin_amdgcn_s_sleep(1); \
    if ((++_sp & 255u) == 0u) { if (xb_ld(&(bar)[XB_TMO])) break; if (_sp > XB_SPIN_CAP) { atomicAdd(&(bar)[XB_TMO], 1u); break; } } } } while (0)

struct XcdBarrier {
    unsigned* bar; unsigned x; int wv;
    volatile LAS unsigned* st;
};

__device__ __forceinline__ XcdBarrier xcd_barrier_post(unsigned* bar, volatile LAS unsigned* st, int wv) {
    XcdBarrier b; b.bar = bar; b.x = xb_xcc_id(); b.st = st; b.wv = wv;
    if (b.wv == 0 && pg8::lane_id() == 0) (void)xb_add(&bar[XB_XCNT(b.x)], 1u);
    return b;
}
__device__ __forceinline__ void xcd_barrier_complete(unsigned* bar, unsigned x, unsigned& nloc, unsigned& nx) {
    const unsigned G = gridDim.x * gridDim.y * gridDim.z;
    unsigned sum, cnt, mine, sp = 0u;
    for (;;) {
        sum = 0u; cnt = 0u; mine = 0u;
#pragma unroll
        for (unsigned j = 0; j < 16; ++j) { const unsigned c = xb_ld(&bar[XB_XCNT(j)]); sum += c; cnt += (c > 0u) ? 1u : 0u; mine = (j == x) ? c : mine; }
        if (sum == G) break;
        __builtin_amdgcn_s_sleep(1);
        if ((++sp & 255u) == 0u) { if (xb_ld(&bar[XB_TMO])) break; if (sp > XB_SPIN_CAP) { atomicAdd(&bar[XB_TMO], 1u); break; } }
    }
    nloc = mine > 0u ? mine : 1u; nx = cnt > 0u ? cnt : 1u;
}

__device__ __forceinline__ void xcd_barrier(const XcdBarrier& b) {
    asm volatile("s_waitcnt vmcnt(0)" ::: "memory");
    __syncthreads();
    if (b.wv == 0 && pg8::lane_id() == 0) {
        unsigned* bar = b.bar;
        __builtin_amdgcn_s_waitcnt(0);
        unsigned nloc = b.st[0], nx = b.st[1];
        if (nloc == 0u) { xcd_barrier_complete(bar, b.x, nloc, nx); b.st[0] = nloc; b.st[1] = nx; }
        const unsigned old = xb_add(&bar[XB_XSUB(b.x)], 1u);
        const unsigned gen = old / nloc;
        if (old + 1u == (gen + 1u) * nloc) {
            __builtin_amdgcn_fence(__ATOMIC_RELEASE, "agent");
            asm volatile("s_waitcnt vmcnt(0)" ::: "memory");
            const unsigned og = xb_add(&bar[XB_TOP], 1u);
            const unsigned tg = og / nx;
            if (og + 1u == (tg + 1u) * nx) xb_add(&bar[XB_TOPGEN], 1u);
            else XB_SPIN(xb_ld(&bar[XB_TOPGEN]) == tg, bar);
            __builtin_amdgcn_fence(__ATOMIC_ACQUIRE, "agent");
            xb_add(&bar[XB_XGEN(b.x)], 1u);
            asm volatile("s_waitcnt vmcnt(0)" ::: "memory");
        } else {
            XB_SPIN(xb_ld(&bar[XB_XGEN(b.x)]) == gen, bar);
            __builtin_amdgcn_fence(__ATOMIC_ACQUIRE, "agent");
            asm volatile("s_waitcnt vmcnt(0)" ::: "memory");
        }
    }
    __syncthreads();
}
struct Frame {
    LAS unsigned char* lds;
    volatile LAS unsigned* MISC;
    unsigned* ctl;
    int tid, lane, wave, G, gw, NGW;
    const float* const* in; float* out; unsigned char* ws;
};
#define WSP(T, off) ((T*)(F.ws + (off)))
#define GIN(k) ((const float*)(const GAS float*)F.in[(k)])

constexpr int NC5 = 129, NC5P = 160;
__device__ __forceinline__ void s5_consts(Frame& F) {
    LAS float* PW = (LAS float*)(F.lds + RING_OFF);
    LAS float* BBr = PW + 17 * 128; LAS float* BBi = BBr + 1024;
    LAS float* Cr = BBi + 1024; LAS float* Ci = Cr + 1024;
    LAS float* K5 = Ci + 1024;
    for (int it = blockIdx.x; it < NL * 32; it += F.G) {
        const int l = it >> 5, g = it & 31;
        __syncthreads();
        if (F.tid < 64) { const int p = F.tid; const size_t idx = (size_t)l * 2048 + g * 64 + p;
            const float are = GIN(23)[idx], aim = GIN(24)[idx]; const float dt = expf(GIN(25)[l * 32 + g]); const float mag = expf(are * dt);
            const float abr = mag * cosf(aim * dt), abi = mag * sinf(aim * dt); const float den = are * are + aim * aim, nre = abr - 1.f;
            const float cor = (nre * are + abi * aim) / den, coi = (abi * are - nre * aim) / den;
            float pr = 1.f, pi = 0.f;
            for (int tau = 0; tau <= 16; ++tau) { PW[(tau * 64 + p) * 2] = pr; PW[(tau * 64 + p) * 2 + 1] = pi; const float nr = pr * abr - pi * abi, ni = pr * abi + pi * abr; pr = nr; pi = ni; }
            const float* Br = GIN(26) + idx * 16; const float* Bi = GIN(27) + idx * 16;
            for (int c2 = 0; c2 < 16; ++c2) { const float br = Br[c2], bi = Bi[c2]; BBr[p * 16 + c2] = cor * br - coi * bi; BBi[p * 16 + c2] = cor * bi + coi * br; }
        }
        for (int i = F.tid; i < 1024; i += NTHR) { Cr[i] = GIN(28)[(size_t)l * 32768 + g * 1024 + i]; Ci[i] = GIN(29)[(size_t)l * 32768 + g * 1024 + i]; }
        __syncthreads();
        for (int o = F.tid; o < 4096; o += NTHR) { const int tau = o >> 8, c = (o >> 4) & 15, c2 = o & 15; float s = 0.f;
            for (int p = 0; p < 64; ++p) { const float pr = PW[(tau * 64 + p) * 2], pi = PW[(tau * 64 + p) * 2 + 1], br = BBr[p * 16 + c2], bi = BBi[p * 16 + c2];
                const float wr = pr * br - pi * bi, wi = pr * bi + pi * br; s += Cr[c * 64 + p] * wr - Ci[c * 64 + p] * wi; }
            if (tau == 0 && c == c2) s += GIN(30)[(size_t)l * 512 + g * 16 + c];
            K5[o] = s; }
        __syncthreads();
        bf16* T5 = WSP(bf16, WS_T5) + ((size_t)l * 32 + g) * 65536; bf16* E5 = WSP(bf16, WS_E5) + ((size_t)l * 32 + g) * 32768; bf16* G5 = WSP(bf16, WS_G5) + ((size_t)l * 32 + g) * 32768;
        for (int o = F.tid; o < 8192; o += NTHR) { const int rho = o >> 5, k8 = (o & 31) * 8, t = rho >> 4, c = rho & 15, tp = k8 >> 4, c2 = k8 & 15;
            unsigned w[4];
#pragma unroll
            for (int j = 0; j < 8; j += 2) { const float a = tp <= t ? K5[((t - tp) * 16 + c) * 16 + c2 + j] : 0.f, b2 = tp <= t ? K5[((t - tp) * 16 + c) * 16 + c2 + j + 1] : 0.f; w[j >> 1] = pk2(a, b2); }
            *(v4u*)(T5 + (size_t)rho * 256 + k8) = (v4u){w[0], w[1], w[2], w[3]}; }
        for (int o = F.tid; o < 4096; o += NTHR) { const int sg = o >> 5, k8 = (o & 31) * 8, p = sg & 63, im = sg >> 6, tp = k8 >> 4, c2 = k8 & 15;
            const float pr = PW[((15 - tp) * 64 + p) * 2], pi = PW[((15 - tp) * 64 + p) * 2 + 1]; float v[8];
#pragma unroll
            for (int j = 0; j < 8; ++j) { const float br = BBr[p * 16 + c2 + j], bi = BBi[p * 16 + c2 + j]; v[j] = im ? (pr * bi + pi * br) : (pr * br - pi * bi); }
            *(v4u*)(E5 + (size_t)sg * 256 + k8) = (v4u){pk2(v[0], v[1]), pk2(v[2], v[3]), pk2(v[4], v[5]), pk2(v[6], v[7])}; }
        for (int o = F.tid; o < 4096; o += NTHR) { const int rho = o >> 4, s8 = (o & 15) * 8, t = rho >> 4, c = rho & 15, im = s8 >> 6, p0 = s8 & 63; float v[8];
#pragma unroll
            for (int j = 0; j < 8; ++j) { const int p = p0 + j; const float pr = PW[((t + 1) * 64 + p) * 2], pi = PW[((t + 1) * 64 + p) * 2 + 1], cr = Cr[c * 64 + p], ci = Ci[c * 64 + p];
                v[j] = im ? -(cr * pi + ci * pr) : (cr * pr - ci * pi); }
            *(v4u*)(G5 + (size_t)rho * 128 + s8) = (v4u){pk2(v[0], v[1]), pk2(v[2], v[3]), pk2(v[4], v[5]), pk2(v[6], v[7])}; }
        if (F.tid < 64) { float* A16 = WSP(float, WS_A16) + ((size_t)l * 32 + g) * 128; A16[F.tid * 2] = PW[(16 * 64 + F.tid) * 2]; A16[F.tid * 2 + 1] = PW[(16 * 64 + F.tid) * 2 + 1]; }
    }
    __syncthreads();
}
__device__ __forceinline__ void s5_egemm(Frame& F, int l) {
    const bf16* P = WSP(bf16, WS_P); float* ES = WSP(float, WS_ES);
    const int nbusy = RW_ITEMS > F.NGW ? (RW_ITEMS - F.NGW < F.G / 2 ? RW_ITEMS - F.NGW : 0) : 0;
    if ((int)blockIdx.x < nbusy) return;
    for (int it = F.wave * (F.G - nbusy) + ((int)blockIdx.x - nbusy); it < NB * 32 * 5 * 4; it += (F.G - nbusy) * NWAVES) {
        int ln = F.lane; asm volatile("" : "+v"(ln));
        const int m = it & 3, nt = (it >> 2) % 5, bg = it / 20, b = bg >> 5, g = bg & 31, r = ln & 31, h2 = ln >> 5, n = 32 * nt + r;
        const bf16* E5 = WSP(bf16, WS_E5) + ((size_t)l * 32 + g) * 32768 + (size_t)(32 * m + r) * 256 + 8 * h2;
        const bool ok = n < NC5; const bf16* up = P + (size_t)(b * TP + 16 * (ok ? n : 0)) * INP + OFF_S + g * 16 + 8 * h2;
        f32x16 acc;
#pragma unroll
        for (int e = 0; e < 16; ++e) acc[e] = 0.f;
#pragma unroll
        for (int s4 = 0; s4 < 16; s4 += 8) { bf16x8 bf[8], af[8];
#pragma unroll
            for (int s = 0; s < 8; ++s) { bf[s] = *(const bf16x8*)(up + (size_t)(s4 + s) * INP); af[s] = *(const bf16x8*)(E5 + 16 * (s4 + s)); }
#pragma unroll
            for (int s = 0; s < 8; ++s) { if (!ok) bf[s] = (bf16x8){0, 0, 0, 0, 0, 0, 0, 0}; acc = MF32(af[s], bf[s], acc); }
            if (m == 0) {
#pragma unroll
                for (int s = 0; s < 8; ++s) *(bf16x8*)(WSP(unsigned char, WS_UT) + ((((size_t)bg * 5 + nt) * 16 + s4 + s) * 64 + ln) * 16) = bf[s]; } }
        float* eo = ES + (((size_t)b * 32 + g) * NC5P + n) * 128 + 32 * m + 4 * h2;
#pragma unroll
        for (int q = 0; q < 4; ++q) *(f32x4*)(eo + 8 * q) = (f32x4){acc[4 * q], acc[4 * q + 1], acc[4 * q + 2], acc[4 * q + 3]};
    }
}
__device__ __forceinline__ void s5_carry(Frame& F, int l, int b, int g) {
    const int p = F.lane; const float* A16 = WSP(float, WS_A16) + ((size_t)l * 32 + g) * 128; const float ar = A16[2 * p], ai = A16[2 * p + 1];
    const float* es = WSP(float, WS_ES) + (((size_t)b * 32 + g) * NC5P) * 128; bf16* xs = WSP(bf16, WS_XS) + (((size_t)b * 32 + g) * NC5P) * 128;
    float xr = 0.f, xi = 0.f;
    for (int c0 = 0; c0 < 132; c0 += 4) {
        float er[4], ei[4];
#pragma unroll
        for (int j = 0; j < 4; ++j) { er[j] = es[(size_t)(c0 + j) * 128 + p]; ei[j] = es[(size_t)(c0 + j) * 128 + 64 + p]; }
#pragma unroll
        for (int j = 0; j < 4; ++j) { if (c0 + j < NC5) { xs[(size_t)(c0 + j) * 128 + p] = (bf16)f2bf(xr); xs[(size_t)(c0 + j) * 128 + 64 + p] = (bf16)f2bf(xi);
            const float nr = ar * xr - ai * xi + er[j], ni = ar * xi + ai * xr + ei[j]; xr = nr; xi = ni; } }
    }
    F.out[O_SRP + ((size_t)l * NB + b) * 2048 + g * 64 + p] = xr; F.out[O_SIP + ((size_t)l * NB + b) * 2048 + g * 64 + p] = xi;
}
__device__ __forceinline__ float gelu_fast_s5(float x) { const float u = -1.5957691216057308f * (x + 0.044715f * x * x * x); return x * __builtin_amdgcn_rcpf(1.f + __expf(u)); }
template <int MH>
__device__ __forceinline__ void s5_ygemm_item(Frame& F, int l, int it) {
    const bf16* P = WSP(bf16, WS_P); bf16* Y5 = WSP(bf16, WS_Y5);
    int ln = F.lane; asm volatile("" : "+v"(ln));
    const int nt = it % 5, bg = it / 5, b = bg >> 5, g = bg & 31, r = ln & 31, h2 = ln >> 5, n = 32 * nt + r;
    const bf16* T5 = WSP(bf16, WS_T5) + ((size_t)l * 32 + g) * 65536; const bf16* G5 = WSP(bf16, WS_G5) + ((size_t)l * 32 + g) * 32768;
    const bool ok = n < NC5; const bf16* up = P + (size_t)(b * TP + 16 * (ok ? n : 0)) * INP + OFF_S + g * 16 + 8 * h2;
    const bf16* xs = WSP(bf16, WS_XS) + (((size_t)b * 32 + g) * NC5P + (ok ? n : 0)) * 128 + 8 * h2;
    f32x16 acc[4];
#pragma unroll
    for (int mm = 0; mm < 4; ++mm)
#pragma unroll
        for (int e = 0; e < 16; ++e) acc[mm][e] = 0.f;
#pragma unroll
    for (int s = 0; s < 14 + 2 * MH; ++s) {
        const bf16x8 bf = *(const bf16x8*)(WSP(unsigned char, WS_UT) + ((((size_t)bg * 5 + nt) * 16 + s) * 64 + ln) * 16);
#pragma unroll
        for (int mm = 0; mm < 4; ++mm) { constexpr int dummy = 0; (void)dummy; const int m = 2 * mm + MH; if (s <= 2 * m + 1) acc[mm] = __builtin_amdgcn_mfma_f32_32x32x16_bf16(*(const bf16x8*)(T5 + (size_t)(32 * m + r) * 256 + 16 * s + 8 * h2), bf, acc[mm], 0, 0, 0); }
    }
#pragma unroll
    for (int s = 0; s < 8; ++s) {
        bf16x8 bf = *(const bf16x8*)(xs + 16 * s);
        if (!ok) bf = (bf16x8){0, 0, 0, 0, 0, 0, 0, 0};
#pragma unroll
        for (int mm = 0; mm < 4; ++mm) { const int m = 2 * mm + MH; acc[mm] = __builtin_amdgcn_mfma_f32_32x32x16_bf16(*(const bf16x8*)(G5 + (size_t)(32 * m + r) * 128 + 16 * s + 8 * h2), bf, acc[mm], 0, 0, 0); }
    }
    if (ok) {
#pragma unroll
        for (int mm = 0; mm < 4; ++mm)
#pragma unroll
            for (int q = 0; q < 4; ++q) { const int m = 2 * mm + MH, t = 2 * m + (q >> 1), c0 = 4 * h2 + 8 * (q & 1);
                v2u w; w.x = pg8::cvt_pk_bf16(gelu_fast_s5(acc[mm][4 * q]), gelu_fast_s5(acc[mm][4 * q + 1])); w.y = pg8::cvt_pk_bf16(gelu_fast_s5(acc[mm][4 * q + 2]), gelu_fast_s5(acc[mm][4 * q + 3]));
                *(v2u*)(Y5 + (size_t)(b * TP + 16 * n + t) * 512 + g * 16 + c0) = w; }
    }
}
__device__ __forceinline__ void s5_ygemm(Frame& F, int l) {
    for (int it = F.gw; it < NB * 32 * 5 * 2; it += F.NGW) { if (it & 1) s5_ygemm_item<1>(F, l, it >> 1); else s5_ygemm_item<0>(F, l, it >> 1); }
}

template <int NIF = 16>
__device__ __forceinline__ void transpose_item(const float* __restrict__ W, int K, int N, bf16* __restrict__ WT, LAS float* scrf, int kb, int nb, int lane, int drow0 = -1, const float* __restrict__ ks = nullptr) {
    LAS unsigned short* scr = (LAS unsigned short*)scrf;
    const int k0 = 64 * kb, n0 = 64 * nb; const int c4 = 4 * (lane & 15), nn = n0 + c4; const bool ok = nn < N; const int d0 = drow0 >= 0 ? drow0 : n0;
#pragma unroll
    for (int hb = 0; hb < 16; hb += NIF) {
        f32x4 vv[NIF];
#pragma unroll
        for (int i = 0; i < NIF; ++i) { const int kk = 4 * (hb + i) + (lane >> 4); vv[i] = (f32x4){0.f, 0.f, 0.f, 0.f}; if (ok) vv[i] = *(const f32x4*)(W + (size_t)(k0 + kk) * N + nn); }
#pragma unroll
        for (int i = 0; i < NIF; ++i) { const int kk = 4 * (hb + i) + (lane >> 4); if (ks) vv[i] = vv[i] * ks[k0 + kk]; *(LAS v2u*)(scr + kk * 66 + c4) = (v2u){pk2(vv[i].x, vv[i].y), pk2(vv[i].z, vv[i].w)}; }
    }
    LDS_WAIT(); asm volatile("" ::: "memory");
    const int c = lane & 7;
#pragma unroll
    for (int i = 0; i < 8; ++i) { const int n = (lane >> 3) + 8 * i; const LAS unsigned short* sp = scr + (8 * c) * 66 + n;
        v4u o; o.x = (unsigned)sp[0] | ((unsigned)sp[66] << 16); o.y = (unsigned)sp[2 * 66] | ((unsigned)sp[3 * 66] << 16); o.z = (unsigned)sp[4 * 66] | ((unsigned)sp[5 * 66] << 16); o.w = (unsigned)sp[6 * 66] | ((unsigned)sp[7 * 66] << 16);
        *(v4u*)(WT + (size_t)(d0 + n) * K + k0 + 8 * c) = o; }
    LDS_WAIT(); asm volatile("" ::: "memory");
}
template <int NIF = 16>
__device__ __forceinline__ void weight_copies(Frame& F, int l, int w0, int wstride, LAS float* scr) {
    constexpr int I_IN = (D / 64) * (INP / 64), I_OUT = (D / 64) * (D / 64), I_UP = (D / 64) * (FF2 / 64), I_DN = (FF / 64) * (D / 64), I_GL = (512 / 64) * (512 / 64), I_L = I_IN + I_OUT + I_UP + I_DN + I_GL;
    for (int it = w0; it < I_L; it += wstride) {
        int r = it;
        if (r < I_IN) { transpose_item<NIF>(GIN(11) + (size_t)l * D * INC, D, INC, WSP(bf16, WS_WIN) + (size_t)l * INP * D, scr, r / (INP / 64), r % (INP / 64), F.lane, -1, GIN(10) + (size_t)l * D); continue; } r -= I_IN;
        if (r < I_OUT) { transpose_item<NIF>(GIN(12) + (size_t)l * D * D, D, D, WSP(bf16, WS_WOUT) + (size_t)l * D * D, scr, r / (D / 64), r % (D / 64), F.lane); continue; } r -= I_OUT;
        if (r < I_UP) { const int nb = r % (FF2 / 64), n0 = 64 * nb;
            const int dr = n0 < FF ? (n0 >> 7) * 256 + (n0 & 127) : ((n0 - FF) >> 7) * 256 + 128 + ((n0 - FF) & 127);
            transpose_item<NIF>(GIN(39) + (size_t)l * D * FF2, D, FF2, WSP(bf16, WS_WUP) + (size_t)l * FF2 * D, scr, r / (FF2 / 64), nb, F.lane, dr, GIN(38) + (size_t)l * D); continue; } r -= I_UP;
        if (r < I_DN) { transpose_item<NIF>(GIN(42) + (size_t)l * FF * D, FF, D, WSP(bf16, WS_WDN) + (size_t)l * D * FF, scr, r / (D / 64), r % (D / 64), F.lane); continue; } r -= I_DN;
        transpose_item<NIF>(GIN(31) + (size_t)l * 512 * 512, 512, 512, WSP(bf16, WS_WGLUT) + (size_t)l * 512 * 512, scr, r / 8, r % 8, F.lane);
    }
}
__device__ __forceinline__ void p0_prologue(Frame& F) {
    s5_consts(F);
    LAS float* scr = (LAS float*)(F.lds + RING_OFF + F.wave * 16384);
    const int nb5 = NL * 32 < F.G ? NL * 32 : 0, V = 2 * nb5 + 3 * (F.G - nb5), v0 = (int)blockIdx.x < nb5 ? 2 * (int)blockIdx.x : 2 * nb5 + 3 * ((int)blockIdx.x - nb5), nv = (int)blockIdx.x < nb5 ? 2 : 3;
    for (int k = 0; k < nv; ++k) weight_copies(F, 0, F.wave * V + v0 + k, V * NWAVES, scr);
    bf16* X = WSP(bf16, WS_X);
    for (int k = 0; k < nv; ++k)
    for (int row = F.wave * V + v0 + k; row < M; row += V * NWAVES) {
        const float* src;
        if (row < MP) { const int b = row / TP, t = row % TP; src = t < NMETA ? GIN(9) + (size_t)t * D : GIN(0) + ((size_t)b * SEQ + (t - NMETA)) * D; }
        else src = GIN(1) + (size_t)(row - MP) * D;
        const f32x4* s4 = (const f32x4*)src; v4u* d8 = (v4u*)(X + (size_t)row * D) + F.lane;
        f32x4 v[8]; float ss = 0.f;
#pragma unroll
        for (int j = 0; j < 4; ++j) { v[2 * j] = s4[(F.lane + 64 * j) * 2]; v[2 * j + 1] = s4[(F.lane + 64 * j) * 2 + 1]; }
#pragma unroll
        for (int j = 0; j < 8; ++j) ss += (v[j].x * v[j].x + v[j].y * v[j].y) + (v[j].z * v[j].z + v[j].w * v[j].w);
#pragma unroll
        for (int j = 0; j < 4; ++j) { v4u w; w.x = pk2(v[2 * j].x, v[2 * j].y); w.y = pk2(v[2 * j].z, v[2 * j].w); w.z = pk2(v[2 * j + 1].x, v[2 * j + 1].y); w.w = pk2(v[2 * j + 1].z, v[2 * j + 1].w); d8[64 * j] = w; }
        const float sst = wave_sum(ss);
        if (F.lane < 32) WSP(float, WS_SSQ)[(size_t)row * 32 + F.lane] = F.lane == 0 ? sst : 0.f;
    }
    { const size_t gt = (size_t)F.gw * 64 + F.lane, GT = (size_t)F.NGW * 64; const v4u z = {0u, 0u, 0u, 0u};
      v4u* sq0 = (v4u*)(WSP(float, WS_SSQ) + (size_t)M * 32); for (size_t i = gt; i < (size_t)(MPAD - M) * 32 / 4; i += GT) sq0[i] = z;
      v4u* ax = (v4u*)(WSP(bf16, WS_X) + (size_t)M * D); for (size_t i = gt; i < (size_t)(MPAD - M) * D / 8; i += GT) ax[i] = z;
      v4u* b = (v4u*)(WSP(bf16, WS_MIX) + (size_t)M * D); for (size_t i = gt; i < (size_t)(MPAD - M) * D / 8; i += GT) b[i] = z;
      v4u* y5 = (v4u*)(WSP(bf16, WS_Y5) + (size_t)M * 512); for (size_t i = gt; i < (size_t)(MPAD - M) * 512 / 8; i += GT) y5[i] = z;
      v4u* c = (v4u*)(WSP(bf16, WS_ACT) + (size_t)M * FF); for (size_t i = gt; i < (size_t)(MPAD - M) * FF / 8; i += GT) c[i] = z;
      float* AB = WSP(float, WS_AB); float* BB = WSP(float, WS_BB); float* LB = WSP(float, WS_LB);
      for (size_t idx = gt; idx < (size_t)NL * 2048; idx += GT) {
          const int l = (int)(idx / 2048), i = (int)(idx % 2048), g = i >> 6;
          const float are = GIN(23)[idx], aim = GIN(24)[idx];
          const float dt = expf(GIN(25)[l * 32 + g]);
          const float mag = expf(are * dt);
          const float abr = mag * cosf(aim * dt), abi = mag * sinf(aim * dt);
          const float den = are * are + aim * aim, nre = abr - 1.f;
          const float cor = (nre * are + abi * aim) / den, coi = (abi * are - nre * aim) / den;
          AB[(size_t)l * 4096 + i] = abr; AB[(size_t)l * 4096 + 2048 + i] = abi;
          const float* Br = GIN(26) + idx * 16; const float* Bi = GIN(27) + idx * 16;
          for (int c2 = 0; c2 < 16; ++c2) { const float br = Br[c2], bi = Bi[c2]; BB[(size_t)l * 65536 + i * 16 + c2] = cor * br - coi * bi; BB[(size_t)l * 65536 + 32768 + i * 16 + c2] = cor * bi + coi * br; }
      }
      { bf16* WU = WSP(bf16, WS_WUPT); bf16* AU = WSP(bf16, WS_AUPT); bf16* GU = WSP(bf16, WS_GUPT);
        for (size_t idx = gt; idx < (size_t)NL * 512 * 64; idx += GT) { const int l2 = (int)(idx / (512 * 64)), col = (int)((idx / 64) % 512), k2 = (int)(idx % 64);
            WU[idx] = (bf16)f2bf(GIN(15)[((size_t)l2 * 64 + k2) * 512 + col]); AU[idx] = (bf16)f2bf(GIN(17)[((size_t)l2 * 64 + k2) * 512 + col]); }
        for (size_t idx = gt; idx < (size_t)NL * 512 * 128; idx += GT) { const int l2 = (int)(idx / (512 * 128)), col = (int)((idx / 128) % 512), k2 = (int)(idx % 128);
            GU[idx] = (bf16)f2bf(GIN(18)[((size_t)l2 * 128 + k2) * 512 + col]); } }
      for (size_t c2 = gt; c2 < 512; c2 += GT) {
          const float* lr = GIN(33); float mx = -1e30f;
#pragma unroll
          for (int l = 0; l < NL; ++l) mx = fmaxf(mx, lr[l * 512 + c2]);
          float sum = 0.f;
#pragma unroll
          for (int l = 0; l < NL; ++l) sum += expf(lr[l * 512 + c2] - mx);
          const float e0 = expf(lr[c2] - mx) / sum; float cum = 0.f;
#pragma unroll
          for (int l = 0; l < NL; ++l) { cum += expf(lr[l * 512 + c2] - mx) / sum; LB[l * 512 + c2] = cum - e0; }
      }
    }
}

__device__ __forceinline__ void slab_table(Frame& F, int KS, pg8::SplitTailOrder& S) {
    LAS int* tab = (LAS int*)(F.lds + RING_OFF);
    S.init2(MPAD, D, KS, F.G, 0);
    __syncthreads();
    for (int i = F.tid; i < (MPAD / 256) * 8; i += NTHR) tab[i] = -1;
    __syncthreads();
    if (F.tid < S.rem) { pg8::StaticOrder t = S; t.c = F.tid; pg8::Unit u; if (t.next(S.full, u)) tab[u.pm * 8 + u.pn] = F.tid * S.P; }
    __syncthreads();
}
__device__ __forceinline__ void unpack8(const v4u a, float (&o)[8]);
__device__ __forceinline__ v4u pack8(const float (&o)[8]) { v4u w; w.x = pg8::cvt_pk_bf16(o[0], o[1]); w.y = pg8::cvt_pk_bf16(o[2], o[3]); w.z = pg8::cvt_pk_bf16(o[4], o[5]); w.w = pg8::cvt_pk_bf16(o[6], o[7]); return w; }
__device__ __forceinline__ void load_xrow(bf16* __restrict__ X, int row, int lane, bool fold, const LAS int* tab, const float* slab, int SP, bool wb, float (&v)[4][8]) {
    v4u* xr = (v4u*)(X + (size_t)row * D) + lane;
    v4u raw[4];
#pragma unroll
    for (int j = 0; j < 4; ++j) raw[j] = xr[64 * j];
#pragma unroll
    for (int j = 0; j < 4; ++j) unpack8(raw[j], v[j]);
    if (fold) {
#pragma unroll
        for (int j = 0; j < 4; ++j) { const int sb = tab[(row >> 8) * 8 + 2 * j + (lane >> 5)];
            if (sb >= 0) { const bf16* sp = (const bf16*)slab + (size_t)sb * 65536 + (size_t)(row & 255) * 256 + 8 * (lane & 31);
                for (int p = 0; p < SP; ++p) { float a[8]; unpack8(*(const v4u*)(sp + (size_t)p * 65536), a);
#pragma unroll
                    for (int e = 0; e < 8; ++e) v[j][e] += a[e]; }
                const v4u w = pack8(v[j]); unpack8(w, v[j]); if (wb) xr[64 * j] = w; } }
    }
}
__device__ __forceinline__ void norm_rows(Frame& F, bf16* __restrict__ X, const float* __restrict__ g, bf16* __restrict__ XN, int KS) {
    pg8::SplitTailOrder S; const LAS int* tab = (const LAS int*)(F.lds + RING_OFF); const float* slab = WSP(float, WS_SLAB);
    if (KS) slab_table(F, KS, S);
    for (int row = F.gw; row < M; row += F.NGW) {
        float v[4][8]; load_xrow(X, row, F.lane, KS != 0, tab, slab, S.P, true, v);
        float s = 0.f;
#pragma unroll
        for (int j = 0; j < 4; ++j)
#pragma unroll
            for (int e = 0; e < 8; ++e) s += v[j][e] * v[j][e];
        const float r = rsqrtf(wave_sum(s) * (1.f / D) + EPS);
        v4u* o8 = (v4u*)(XN + (size_t)row * D) + F.lane;
#pragma unroll
        for (int j = 0; j < 4; ++j) { const f32x4 g0 = ((const f32x4*)g)[(F.lane + 64 * j) * 2], g1 = ((const f32x4*)g)[(F.lane + 64 * j) * 2 + 1];
            float o[8] = {v[j][0] * r * g0.x, v[j][1] * r * g0.y, v[j][2] * r * g0.z, v[j][3] * r * g0.w, v[j][4] * r * g1.x, v[j][5] * r * g1.y, v[j][6] * r * g1.z, v[j][7] * r * g1.w};
            o8[64 * j] = pack8(o); }
    }
    if (KS) __syncthreads();
}
__device__ __forceinline__ void final_rows(Frame& F, bf16* __restrict__ X, const float* __restrict__ g, float* __restrict__ out) {
    pg8::SplitTailOrder S; const LAS int* tab = (const LAS int*)(F.lds + RING_OFF); const float* slab = WSP(float, WS_SLAB);
    slab_table(F, FF, S);
    for (int row = F.gw; row < M; row += F.NGW) {
        float* o;
        if (row < MP) { const int b = row / TP, t = row % TP; if (t < NMETA) continue; o = out + O_YP + ((size_t)b * SEQ + (t - NMETA)) * D; }
        else o = out + O_YS + (size_t)(row - MP) * D;
        float v[4][8]; load_xrow(X, row, F.lane, true, tab, slab, S.P, false, v);
        float s = 0.f;
#pragma unroll
        for (int j = 0; j < 4; ++j)
#pragma unroll
            for (int e = 0; e < 8; ++e) s += v[j][e] * v[j][e];
        const float r = rsqrtf(wave_sum(s) * (1.f / D) + EPS);
        f32x4* o4 = (f32x4*)o;
#pragma unroll
        for (int j = 0; j < 4; ++j) { const f32x4 g0 = ((const f32x4*)g)[(F.lane + 64 * j) * 2], g1 = ((const f32x4*)g)[(F.lane + 64 * j) * 2 + 1];
            f32x4 a = {v[j][0] * r * g0.x, v[j][1] * r * g0.y, v[j][2] * r * g0.z, v[j][3] * r * g0.w}, b2 = {v[j][4] * r * g1.x, v[j][5] * r * g1.y, v[j][6] * r * g1.z, v[j][7] * r * g1.w};
            o4[(F.lane + 64 * j) * 2] = a; o4[(F.lane + 64 * j) * 2 + 1] = b2; }
    }
}

__device__ __forceinline__ void mix_pre(Frame& F, int l) {
    LAS float* ps = (LAS float*)(F.lds + RING_OFF);
    LAS float* lo = ps + RC;
    LAS float* kkn = lo + 256;
    const bf16* P = WSP(bf16, WS_P);
    const float* shift_in = GIN(3) + (size_t)l * NS * RC; const float* mu = GIN(13) + (size_t)l * RC;
    const float* w0 = GIN(14) + (size_t)l * 512; const float* w_up = GIN(15) + (size_t)l * 64 * 512;
    const float* a0 = GIN(16) + (size_t)l * 512; const float* a_up = GIN(17) + (size_t)l * 64 * 512; const float* g_up = GIN(18) + (size_t)l * 128 * 512;
    const float* k_k = GIN(19) + (size_t)l * 512; const float* k_a = GIN(20) + (size_t)l * 512;
    float* shp = F.out + O_SHP + (size_t)l * NB * RC; float* shs = F.out + O_SHS + (size_t)l * NS * RC;
    float* RW = WSP(float, WS_RW); const size_t st = (size_t)M * 512;
    const float* lb = WSP(float, WS_LB) + (size_t)l * 512;
    float* HQ = WSP(float, WS_HQ); float* HK = WSP(float, WS_HK); float* GQ = WSP(float, WS_GQ); float* GD = WSP(float, WS_GD);
    const float* gk_up = GIN(35) + (size_t)l * 16 * 256; const float* gk_b = GIN(36) + (size_t)l * 256;
    if (blockIdx.x < NB) { const bf16* pl = P + (size_t)(blockIdx.x * TP + TP - 1) * INP; for (int i = F.tid; i < RC; i += NTHR) shp[(size_t)blockIdx.x * RC + i] = bf2f(pl[i]); }
    const int nbusy = RW_ITEMS > F.NGW ? (RW_ITEMS - F.NGW < F.G / 2 ? RW_ITEMS - F.NGW : 0) : 0;
    static_assert(MS == NS * TS && TS == 4, "sample sequences of 4 rows");
    LAS float* lo4 = ps + TS * RC;
    LAS float* kk4 = lo4 + TS * 256;
    for (int sq = (int)blockIdx.x - nbusy; (int)blockIdx.x >= nbusy && sq < NS; sq += F.G - nbusy) {
        const int row0 = MP + sq * TS; const bf16* p0 = P + (size_t)row0 * INP;
        __syncthreads();
        for (int i = F.tid; i < RC; i += NTHR) {
            float prev = shift_in[(size_t)sq * RC + i]; const float m = mu[i];
            float cur4[TS];
#pragma unroll
            for (int q = 0; q < TS; ++q) cur4[q] = bf2f(p0[(size_t)q * INP + i]);
#pragma unroll
            for (int q = 0; q < TS; ++q) { ps[q * RC + i] = cur4[q] + (prev - cur4[q]) * m; prev = cur4[q]; }
            shs[(size_t)sq * RC + i] = prev;
        }
        __syncthreads();
        for (int e = F.tid; e < TS * 256; e += NTHR) { const int q = e >> 8, i = e & 255; const LAS float* pq = ps + q * RC; float v; if (i < 64) v = tanhf(pq[1536 + i]); else if (i < 128) v = pq[1536 + i]; else v = sigmoidf_(pq[1664 + (i - 128)]); lo4[q * 256 + i] = v; }
        __syncthreads();
        const int c = F.tid;
        float lw[TS], la[TS], g[TS];
#pragma unroll
        for (int q = 0; q < TS; ++q) { lw[q] = w0[c]; la[q] = a0[c]; g[q] = 0.f; }
        { const bf16* wu = WSP(bf16, WS_WUPT) + ((size_t)l * 512 + c) * 64; const bf16* au = WSP(bf16, WS_AUPT) + ((size_t)l * 512 + c) * 64; const bf16* gu = WSP(bf16, WS_GUPT) + ((size_t)l * 512 + c) * 128;
#pragma unroll 1
          for (int q8 = 0; q8 < 8; ++q8) { float a8[8], b8[8]; unpack8(*(const v4u*)(wu + 8 * q8), a8); unpack8(*(const v4u*)(au + 8 * q8), b8);
#pragma unroll
              for (int q = 0; q < TS; ++q)
#pragma unroll
                  for (int j = 0; j < 8; ++j) { lw[q] += lo4[q * 256 + 8 * q8 + j] * a8[j]; la[q] += lo4[q * 256 + 64 + 8 * q8 + j] * b8[j]; } }
#pragma unroll 1
          for (int q8 = 0; q8 < 16; ++q8) { float a8[8]; unpack8(*(const v4u*)(gu + 8 * q8), a8);
#pragma unroll
              for (int q = 0; q < TS; ++q)
#pragma unroll
                  for (int j = 0; j < 8; ++j) g[q] += lo4[q * 256 + 128 + 8 * q8 + j] * a8[j]; } }
        float kkv[TS], av[TS];
        const float kkc = k_k[c], kac = k_a[c];
#pragma unroll
        for (int q = 0; q < TS; ++q) { const LAS float* pq = ps + q * RC;
            const float w = expf(-0.606531f * sigmoidf_(lw[q])), a = sigmoidf_(la[q]), k = pq[512 + c];
            const float kk = k * kkc; const size_t o = (size_t)(row0 + q) * 512 + c;
            RW[0 * st + o] = pq[c]; RW[1 * st + o] = w; RW[2 * st + o] = k * (1.f + (a - 1.f) * kac); RW[3 * st + o] = pq[1024 + c]; RW[6 * st + o] = g[q];
            const float ss = wave_sum(kk * kk);
            if (F.lane == 0) kk4[q * 8 + F.wave] = ss;
            kkv[q] = kk; av[q] = a; }
        __syncthreads();
        float gku[16]; const float gkb = c < 256 ? gk_b[c] : 0.f; const float lbc = lb[c];
        if (c < 256) {
#pragma unroll
            for (int j = 0; j < 16; ++j) gku[j] = gk_up[j * 256 + c]; }
#pragma unroll
        for (int q = 0; q < TS; ++q) { const bf16* pr = p0 + (size_t)q * INP; const size_t o = (size_t)(row0 + q) * 512 + c;
            const float kk = kkv[q] / fmaxf(sqrtf(kk4[q * 8 + (c >> 6)]), 1e-12f);
            RW[4 * st + o] = kk; RW[5 * st + o] = kk * av[q];
            HQ[o] = siluf_(bf2f(pr[OFF_H + c]));
            HK[o] = fminf((1.f - lbc) * sigmoidf_(-bf2f(pr[OFF_H + 512 + c])), 1.f - 1e-4f);
            if (c < 256) { float x = gkb;
#pragma unroll
                for (int j = 0; j < 16; ++j) x += bf2f(pr[OFF_G + 1024 + j]) * gku[j];
                GQ[(size_t)(row0 + q) * 256 + c] = bf2f(pr[OFF_G + c]) * 0.125f; GD[(size_t)(row0 + q) * 256 + c] = expf(log_sigmoidf_(x) * (1.f / 16.f)); } }
    }
}

__device__ __forceinline__ void scan_rwkv(Frame& F, int l, int s, int h, LAS float* scr) {
    const int v = F.lane; int row0, T; seq_rows(s, row0, T);
    const float* RW = WSP(float, WS_RW); const size_t st = (size_t)M * 512;
    float S[64];
    if (s < NB) {
#pragma unroll
        for (int k = 0; k < 64; ++k) S[k] = 0.f;
    } else { const f32x4* si = (const f32x4*)(GIN(2) + ((((size_t)l * NS + (s - NB)) * 8 + h) * 64 + v) * 64);
#pragma unroll
        for (int k = 0; k < 16; ++k) { const f32x4 q = si[k]; S[4 * k] = q.x; S[4 * k + 1] = q.y; S[4 * k + 2] = q.z; S[4 * k + 3] = q.w; } }
    const float rk = GIN(21)[(size_t)l * 512 + h * 64 + v], lg = GIN(22)[(size_t)l * 512 + h * 64 + v];
    bf16* MIX = WSP(bf16, WS_MIX);
    for (int t = 0; t < T; ++t) {
        const size_t o = (size_t)(row0 + t) * 512 + h * 64 + v;
        const float r_ = RW[0 * st + o], w_ = RW[1 * st + o], k_ = RW[2 * st + o], v_ = RW[3 * st + o], kk_ = RW[4 * st + o], ka_ = RW[5 * st + o], g_ = RW[6 * st + o];
        asm volatile("" ::: "memory");
        scr[v] = r_; scr[64 + v] = w_; scr[128 + v] = k_; scr[192 + v] = kk_; scr[256 + v] = ka_;
        LDS_WAIT();
        float sa = 0.f;
#pragma unroll
        for (int k = 0; k < 64; ++k) sa += S[k] * scr[192 + k];
        float y = 0.f;
#pragma unroll
        for (int k = 0; k < 64; ++k) { S[k] = S[k] * scr[64 + k] - sa * scr[256 + k] + v_ * scr[128 + k]; y += S[k] * scr[k]; }
        const float mean = wave_sum(y) * (1.f / 64.f), d = y - mean;
        const float var = wave_sum(d * d) * (1.f / 64.f);
        float yo = d * rsqrtf(var + 64e-5f) * lg;
        yo += wave_sum(r_ * k_ * rk) * v_;
        MIX[(size_t)(row0 + t) * D + h * 64 + v] = (bf16)f2bf(yo * g_);
    }
    float* so = (s < NB) ? F.out + O_RWP + ((((size_t)l * NB + s) * 8 + h) * 64 + v) * 64 : F.out + O_RWS + ((((size_t)l * NS + (s - NB)) * 8 + h) * 64 + v) * 64;
#pragma unroll
    for (int k = 0; k < 16; ++k) ((f32x4*)so)[k] = (f32x4){S[4 * k], S[4 * k + 1], S[4 * k + 2], S[4 * k + 3]};
}
__device__ __forceinline__ void scan_s5(Frame& F, int l, int s, int g) {
    const int p = F.lane, i = g * 64 + p; int row0, T; seq_rows(s, row0, T);
    const float* AB = WSP(float, WS_AB) + (size_t)l * 4096; const float* BB = WSP(float, WS_BB) + (size_t)l * 65536;
    const float abr = AB[i], abi = AB[2048 + i];
    float br[16], bi[16];
#pragma unroll
    for (int c = 0; c < 16; ++c) { br[c] = BB[i * 16 + c]; bi[c] = BB[32768 + i * 16 + c]; }
    float hr = 0.f, hi = 0.f;
    if (s >= NB) { hr = GIN(4)[((size_t)l * NS + (s - NB)) * 2048 + i]; hi = GIN(5)[((size_t)l * NS + (s - NB)) * 2048 + i]; }
    float* HS = WSP(float, WS_HS); const size_t st = (size_t)M * 2048; const bf16* P = WSP(bf16, WS_P);
    for (int t = 0; t < T; ++t) {
        const v4u* u8 = (const v4u*)(P + (size_t)(row0 + t) * INP + OFF_S + g * 16);
        const v4u ua = u8[0], ub = u8[1];
        const float u[16] = {bflo(ua.x), bfhi(ua.x), bflo(ua.y), bfhi(ua.y), bflo(ua.z), bfhi(ua.z), bflo(ua.w), bfhi(ua.w), bflo(ub.x), bfhi(ub.x), bflo(ub.y), bfhi(ub.y), bflo(ub.z), bfhi(ub.z), bflo(ub.w), bfhi(ub.w)};
        float bur = 0.f, bui = 0.f;
#pragma unroll
        for (int c = 0; c < 16; ++c) { bur += br[c] * u[c]; bui += bi[c] * u[c]; }
        const float nr = abr * hr - abi * hi + bur, ni = abr * hi + abi * hr + bui;
        hr = nr; hi = ni;
        HS[(size_t)(row0 + t) * 2048 + i] = hr; HS[st + (size_t)(row0 + t) * 2048 + i] = hi;
    }
    if (s < NB) { F.out[O_SRP + ((size_t)l * NB + s) * 2048 + i] = hr; F.out[O_SIP + ((size_t)l * NB + s) * 2048 + i] = hi; }
    else { F.out[O_SRS + ((size_t)l * NS + (s - NB)) * 2048 + i] = hr; F.out[O_SIS + ((size_t)l * NS + (s - NB)) * 2048 + i] = hi; }
}
template <int KD, bool IS_HGRN>
__device__ __forceinline__ void scan_glr(Frame& F, int l, int s, int h, int vb, LAS float* scr) {
    const int v = vb * 64 + F.lane; int row0, T; seq_rows(s, row0, T);
    const bf16* P = WSP(bf16, WS_P);
    const float* Q = IS_HGRN ? WSP(float, WS_HQ) : WSP(float, WS_GQ); const float* X2 = IS_HGRN ? WSP(float, WS_HK) : WSP(float, WS_GD);
    bf16* ORAW = IS_HGRN ? WSP(bf16, WS_OH) : WSP(bf16, WS_OG);
    constexpr int QW = 4 * KD;
    float S[KD];
    if (s < NB) {
#pragma unroll
        for (int k = 0; k < KD; ++k) S[k] = 0.f;
    } else { const float* si = (IS_HGRN ? GIN(6) : GIN(7)) + (((size_t)l * NS + (s - NB)) * 4 + h) * KD * 128 + v;
#pragma unroll
        for (int k = 0; k < KD; ++k) S[k] = si[(size_t)k * 128]; }
    LAS float* vq = scr; LAS float* vd = scr + KD; LAS float* vk = scr + 2 * KD;
    for (int t = 0; t < T; ++t) {
        const int row = row0 + t;
        asm volatile("" ::: "memory");
#pragma unroll
        for (int k = F.lane; k < KD; k += 64) {
            const float q = Q[(size_t)row * QW + h * KD + k], x2 = X2[(size_t)row * QW + h * KD + k];
            vq[k] = q;
            if (IS_HGRN) { vd[k] = 1.f - x2; vk[k] = x2; } else { vd[k] = x2; vk[k] = bf2f(P[(size_t)row * INP + OFF_G + 256 + h * 64 + k]); }
        }
        const float val = IS_HGRN ? bf2f(P[(size_t)row * INP + OFF_H + 1024 + h * 128 + v]) : bf2f(P[(size_t)row * INP + OFF_G + 512 + h * 128 + v]);
        LDS_WAIT();
        float o = 0.f;
#pragma unroll
        for (int k = 0; k < KD; ++k) { S[k] = vd[k] * S[k] + vk[k] * val; o += vq[k] * S[k]; }
        ORAW[(size_t)row * 512 + h * 128 + v] = (bf16)f2bf(o);
    }
    float* so = IS_HGRN ? ((s < NB) ? F.out + O_HGP + (((size_t)l * NB + s) * 4 + h) * KD * 128 + v : F.out + O_HGS + (((size_t)l * NS + (s - NB)) * 4 + h) * KD * 128 + v)
                        : ((s < NB) ? F.out + O_GLP + (((size_t)l * NB + s) * 4 + h) * KD * 128 + v : F.out + O_GLS + (((size_t)l * NS + (s - NB)) * 4 + h) * KD * 128 + v);
#pragma unroll
    for (int k = 0; k < KD; ++k) so[(size_t)k * 128] = S[k];
}
constexpr int NCH = 65;
constexpr int UB_QT = 0, UB_KT = 4096, UB_AI = 8192, UB_DT = 10240, UB_AT = 12288, UB_BT = 16384;
constexpr int UBG = 12288, UBR = 20480;
constexpr int NU_H = NB * 4 * 2, NU_G = NB * 4, NU_GLR = NU_H + NU_G;
typedef float f32x2v_ __attribute__((ext_vector_type(2)));
typedef __bf16 bf16x2v_ __attribute__((ext_vector_type(2)));
__device__ __forceinline__ unsigned cvtpk(float lo, float hi) { const f32x2v_ v = {lo, hi}; const bf16x2v_ b = __builtin_convertvector(v, bf16x2v_); return __builtin_bit_cast(unsigned, b); }

__device__ __forceinline__ void glr_pre_item(Frame& F, int l, int isG, int b, int hh, int c) {
    LAS float* OS = (LAS float*)(F.lds + RING_OFF);
    LAS unsigned short* QTL = (LAS unsigned short*)(F.lds + RING_OFF + 2048);
    LAS unsigned short* QM = (LAS unsigned short*)(F.lds + RING_OFF + 2048 + 8192);
    LAS unsigned short* KM = QM + 32 * 136;
    LAS unsigned short* QX = KM + 32 * 136;
    LAS unsigned short* KX = QX + 16 * 136;
    const bf16* P = WSP(bf16, WS_P);
    const int kc = F.tid & 127, q = F.tid >> 7, un = kc >> 6, kl = kc & 63;
    const int head = isG ? 2 * hh + un : hh;
    const int unit = isG ? NU_H + b * 4 + head : (b * 4 + hh) * 2 + un;
    unsigned char* ub = F.ws + WS_GU + ((size_t)unit * NCH + c) * UBG;
    float qs[8], kin[8], bc[8];
    const float lbv = isG ? 0.f : WSP(float, WS_LB)[(size_t)l * 512 + hh * 128 + kc];
    const float gkb = isG ? GIN(36)[(size_t)l * 256 + head * 64 + kl] : 0.f;
    float gku[16];
    if (isG) {
#pragma unroll
        for (int j = 0; j < 16; ++j) gku[j] = GIN(35)[((size_t)l * 16 + j) * 256 + head * 64 + kl];
    }
    float run = 0.f;
#pragma unroll
    for (int i = 0; i < 8; ++i) {
        const int t = 32 * c + 8 * q + i; const bool ok = t < TP;
        const bf16* p = P + (size_t)(b * TP + (ok ? t : 0)) * INP;
        float qv, kv, ld;
        if (!isG) { const float q0 = bf2f(p[OFF_H + hh * 128 + kc]); qv = q0 * __builtin_amdgcn_rcpf(1.f + __expf(-q0)); kv = fminf((1.f - lbv) * __builtin_amdgcn_rcpf(1.f + __expf(bf2f(p[OFF_H + 512 + hh * 128 + kc]))), 1.f - 1e-4f); ld = __logf(1.f - kv); }
        else { qv = bf2f(p[OFF_G + head * 64 + kl]) * 0.125f; kv = bf2f(p[OFF_G + 256 + head * 64 + kl]);
            const v4u g0 = *(const v4u*)(p + OFF_G + 1024), g1 = *(const v4u*)(p + OFF_G + 1032);
            float x = gkb;
            x += bflo(g0.x) * gku[0] + bfhi(g0.x) * gku[1] + bflo(g0.y) * gku[2] + bfhi(g0.y) * gku[3] + bflo(g0.z) * gku[4] + bfhi(g0.z) * gku[5] + bflo(g0.w) * gku[6] + bfhi(g0.w) * gku[7];
            x += bflo(g1.x) * gku[8] + bfhi(g1.x) * gku[9] + bflo(g1.y) * gku[10] + bfhi(g1.y) * gku[11] + bflo(g1.z) * gku[12] + bfhi(g1.z) * gku[13] + bflo(g1.w) * gku[14] + bfhi(g1.w) * gku[15];
            ld = (fminf(x, 0.f) - __logf(1.f + __expf(-fabsf(x)))) * (1.f / 16.f); }
        if (!ok) { qv = 0.f; kv = 0.f; ld = 0.f; }
        run += ld; qs[i] = qv; kin[i] = kv; bc[i] = run;
    }
    __syncthreads();
    OS[q * 128 + kc] = run;
    __syncthreads();
    const float o0 = OS[kc], o1 = OS[128 + kc], o2 = OS[256 + kc], o3 = OS[384 + kc];
    const float r7 = o0, r15 = o0 + o1, r23 = r15 + o2, r31 = r23 + o3;
    const float pre = q == 0 ? 0.f : (q == 1 ? r7 : (q == 2 ? r15 : r23));
    const float rblk = q < 2 ? r7 : r23;
    unsigned kt[4];
#pragma unroll
    for (int i = 0; i < 8; i += 2) {
        const float b0 = bc[i] + pre, b1 = bc[i + 1] + pre;
        kt[i >> 1] = pk2(kin[i] * __expf(r31 - b0), kin[i + 1] * __expf(r31 - b1));
    }
    { const int m = kl >> 5, r = kl & 31, s2 = q >> 1, h2 = q & 1;
      *(v4u*)(ub + UB_KT + (((m * 2 + s2) * 2 + h2) * 32 + r) * 16) = (v4u){kt[0], kt[1], kt[2], kt[3]}; }
    if (q == 3) *(float*)(ub + UB_DT + kl * 4) = __expf(r31);
#pragma unroll
    for (int i = 0; i < 8; ++i) {
        const int t = 8 * q + i; const float bt = bc[i] + pre;
        { const int s = kl >> 4, h2 = (kl >> 2) & 1, j = ((kl >> 3) & 1) * 4 + (kl & 3);
          QTL[un * 2048 + ((s * 2 + h2) * 32 + t) * 8 + j] = (unsigned short)f2bf(qs[i] * __expf(bt)); }
        QM[t * 136 + kc] = (unsigned short)f2bf(qs[i] * __expf(bt - rblk));
        KM[t * 136 + kc] = (unsigned short)f2bf(kin[i] * __expf(rblk - bt));
        if (q >= 2) QX[(t - 16) * 136 + kc] = (unsigned short)f2bf(qs[i] * __expf(bt - r15));
        else KX[t * 136 + kc] = (unsigned short)f2bf(kin[i] * __expf(r15 - bt));
    }
    for (int pass = 0; pass < (isG ? 2 : 1); ++pass) {
        const int vcol = kc + 128 * pass, hd = isG ? 2 * hh + (vcol >> 7) : hh, v = vcol & 127;
        unsigned w[4];
#pragma unroll
        for (int i = 0; i < 8; i += 2) {
            const int t = 32 * c + 8 * q + i;
            const bf16* p0 = P + (size_t)(b * TP + (t < TP ? t : 0)) * INP; const bf16* p1 = P + (size_t)(b * TP + (t + 1 < TP ? t + 1 : 0)) * INP;
            const int off = isG ? OFF_G + 512 + hd * 128 + v : OFF_H + 1024 + hd * 128 + v;
            const unsigned a0 = t < TP ? p0[off] : 0u, a1 = t + 1 < TP ? p1[off] : 0u;
            w[i >> 1] = a0 | (a1 << 16);
        }
        unsigned char* vt = F.ws + WS_GV + ((((size_t)b * 8 + (isG ? 4 : 0) + hd) * NCH + c) * 4 + (v >> 5)) * 2048;
        *(v4u*)(vt + (((q >> 1) * 2 + (q & 1)) * 32 + (v & 31)) * 16) = (v4u){w[0], w[1], w[2], w[3]};
    }
    __syncthreads();
    { const int u2 = F.tid >> 8, o16 = F.tid & 255;
      const int unit2 = isG ? NU_H + b * 4 + 2 * hh + u2 : (b * 4 + hh) * 2 + u2;
      *(v4u*)(F.ws + WS_GU + ((size_t)unit2 * NCH + c) * UBG + UB_QT + o16 * 16) = *(const LAS v4u*)((const LAS unsigned char*)QTL + u2 * 4096 + o16 * 16); }
    { const int w4 = F.wave & 3, grp = F.wave >> 2;
      if (isG || grp == 0) {
          const int k0 = isG ? 64 * grp : 0, nks = isG ? 2 : 4;
          const int hdA = isG ? 2 * hh + grp : hh;
          const int unitA = isG ? NU_H + b * 4 + hdA : (b * 4 + hh) * 2;
          unsigned char* ai = F.ws + WS_GU + ((size_t)unitA * NCH + c) * UBG + UB_AI;
          const int rr = F.lane & 15, kg = F.lane >> 4;
          if (w4 < 3) {
              const int bi = w4 == 0 ? 0 : 1, bj = w4 == 1 ? 1 : 0;
              const LAS unsigned short* qa = (w4 == 2 ? QX + rr * 136 : QM + (16 * bi + rr) * 136) + k0 + 8 * kg;
              const LAS unsigned short* kb = (w4 == 2 ? KX + rr * 136 : KM + (16 * bj + rr) * 136) + k0 + 8 * kg;
              f32x4 acc = {0.f, 0.f, 0.f, 0.f};
              for (int ks = 0; ks < nks; ++ks) acc = __builtin_amdgcn_mfma_f32_16x16x32_bf16(*(const LAS bf16x8*)(qa + 32 * ks), *(const LAS bf16x8*)(kb + 32 * ks), acc, 0, 0, 0);
              const int jj = rr;
#pragma unroll
              for (int e = 0; e < 4; ++e) { const int ii = 4 * kg + e; float val = acc[e]; if (w4 < 2 && jj > ii) val = 0.f;
                  const int t = 16 * bi + ii, tp = 16 * bj + jj;
                  *(unsigned short*)(ai + (((tp >> 4) * 2 + ((tp >> 3) & 1)) * 32 + t) * 16 + (tp & 7) * 2) = (unsigned short)f2bf(val); }
          } else if (F.lane < 32) {
              const int t = F.lane & 15, h2 = F.lane >> 4;
              unsigned z0 = 0u; asm volatile("" : "+v"(z0)); *(v4u*)(ai + ((1 * 2 + h2) * 32 + t) * 16) = (v4u){z0, z0, z0, z0};
          }
      }
    }
}
__device__ __forceinline__ void glr_pre(Frame& F, int l, int mode, int widx, int wcount, int NI_W) {
    constexpr int NI = 24 * NCH;
    const int lo = mode ? NI_W : 0, hi = mode ? NI : NI_W;
    for (int it = lo + widx; it < hi; it += wcount) { const int c = it / 24, u = it % 24;
        if (u < 16) glr_pre_item(F, l, 0, u >> 2, u & 3, c); else glr_pre_item(F, l, 1, (u - 16) >> 1, (u - 16) & 1, c); }
    __syncthreads();
}

__device__ __forceinline__ bf16x8 acc2frag(const f32x16& S, int half) {
    union { unsigned u[4]; bf16x8 v; } x;
    x.u[0] = cvtpk(S[8 * half + 0], S[8 * half + 1]); x.u[1] = cvtpk(S[8 * half + 2], S[8 * half + 3]); x.u[2] = cvtpk(S[8 * half + 4], S[8 * half + 5]); x.u[3] = cvtpk(S[8 * half + 6], S[8 * half + 7]);
    return x.v;
}
#ifndef SCAN_WAIT
#define SCAN_WAIT 0x4F70
#define SCAN_WAIT_RW 0x4F78
#endif
template <bool RW>
__device__ __forceinline__ void scan_pipe(Frame& F, const unsigned char* ub, size_t ubs, const unsigned char* uai, const unsigned char* vt, size_t vts, bf16* obuf, int ldo, float* sout, int st_k, int st_v) {
    LAS float* dl = (LAS float*)(F.lds + RING_OFF + F.wave * 16384);
    int lane = F.lane, r = lane & 31, h2 = lane >> 5;
    f32x16 S0, S1;
#pragma unroll
    for (int e = 0; e < 16; ++e) { S0[e] = 0.f; S1[e] = 0.f; }
    bf16x8 qA[4], aA[4], iA[2], vA[2], kA[2][2], qB[4], aB[4], iB[2], vB[2], kB[2][2], bt[2][2]; float dA, dB;
#define SCAN_LOAD1(c_, Q, A_, I_, V_, K_, DD, BT_) do { const int cc_ = (c_) < NCH ? (c_) : NCH - 1; const unsigned char* u_ = ub + (size_t)cc_ * ubs; const unsigned char* v_ = vt + (size_t)cc_ * vts; \
        _Pragma("unroll") for (int s = 0; s < 4; ++s) { Q[s] = *(const bf16x8*)(u_ + UB_QT + (s * 64 + lane) * 16); if (RW) A_[s] = *(const bf16x8*)(u_ + UB_AT + (s * 64 + lane) * 16); } \
        if (!RW) { _Pragma("unroll") for (int m = 0; m < 2; ++m) _Pragma("unroll") for (int s = 0; s < 2; ++s) K_[m][s] = *(const bf16x8*)(u_ + UB_KT + ((m * 2 + s) * 64 + lane) * 16); } \
        _Pragma("unroll") for (int s = 0; s < 2; ++s) { V_[s] = *(const bf16x8*)(v_ + (s * 64 + lane) * 16); if (uai) I_[s] = *(const bf16x8*)(uai + (size_t)cc_ * ubs + UB_AI + (s * 64 + lane) * 16); } \
        DD = *(const float*)(u_ + UB_DT + lane * 4); } while (0)
#define SCAN_LOADBT(c_) do { const int cb_ = (c_) < NCH ? (c_) : NCH - 1; const unsigned char* u_ = ub + (size_t)cb_ * ubs; \
        _Pragma("unroll") for (int m = 0; m < 2; ++m) _Pragma("unroll") for (int s = 0; s < 2; ++s) { kA[m][s] = *(const bf16x8*)(u_ + UB_KT + ((m * 2 + s) * 64 + lane) * 16); bt[m][s] = *(const bf16x8*)(u_ + UB_BT + ((m * 2 + s) * 64 + lane) * 16); } } while (0)
#define SCAN_BODY(c_, Q, A_, I_, V_, K_, DD, PRED_) do { \
        dl[lane] = DD; \
        const bf16x8 sb0 = acc2frag(S0, 0), sb1 = acc2frag(S0, 1), sb2 = acc2frag(S1, 0), sb3 = acc2frag(S1, 1); \
        bf16x8 ub0, ub1; \
        if (RW) { f32x16 Ut; _Pragma("unroll") for (int e = 0; e < 16; ++e) Ut[e] = 0.f; \
            Ut = MF32(A_[0], sb0, Ut); Ut = MF32(A_[1], sb1, Ut); Ut = MF32(A_[2], sb2, Ut); Ut = MF32(A_[3], sb3, Ut); \
            _Pragma("unroll") for (int e = 0; e < 16; ++e) Ut[e] = -Ut[e]; \
            ub0 = acc2frag(Ut, 0); ub1 = acc2frag(Ut, 1); } \
        f32x16 O; \
        _Pragma("unroll") for (int e = 0; e < 16; ++e) O[e] = 0.f; \
        O = MF32(Q[0], sb0, O); O = MF32(Q[1], sb1, O); O = MF32(Q[2], sb2, O); O = MF32(Q[3], sb3, O); \
        if (uai) { O = MF32(I_[0], V_[0], O); O = MF32(I_[1], V_[1], O); } \
        _Pragma("unroll") for (int e = 0; e < 16; ++e) { const int t = 32 * (c_) + (e & 3) + 8 * (e >> 2) + 4 * h2; if (!(PRED_) || t < TP) obuf[(size_t)t * ldo + r] = (bf16)pg8::cvt_pk_bf16(O[e], 0.f); }   \
        _Pragma("unroll") for (int g = 0; g < 4; ++g) { const f32x4 d0 = *(const LAS f32x4*)(dl + 8 * g + 4 * h2), d1 = *(const LAS f32x4*)(dl + 32 + 8 * g + 4 * h2); \
            _Pragma("unroll") for (int j = 0; j < 4; ++j) { S0[4 * g + j] *= d0[j]; S1[4 * g + j] *= d1[j]; } } \
        S0 = MF32(K_[0][0], V_[0], S0); S0 = MF32(K_[0][1], V_[1], S0); S1 = MF32(K_[1][0], V_[0], S1); S1 = MF32(K_[1][1], V_[1], S1); \
        if (RW) { \
            S0 = MF32(bt[0][0], ub0, S0); S0 = MF32(bt[0][1], ub1, S0); S1 = MF32(bt[1][0], ub0, S1); S1 = MF32(bt[1][1], ub1, S1); } \
        asm volatile("" ::: "memory"); } while (0)
    static_assert(NCH % 2 == 1 && 32 * (NCH - 1) <= TP, "chunk 0 and the last pair are peeled; only the last chunk is partial");
    SCAN_LOAD1(0, qA, aA, iA, vA, kA, dA, 0);
    __builtin_amdgcn_s_waitcnt(0x0F70);
    if (RW) SCAN_LOADBT(0);
    SCAN_LOAD1(1, qB, aB, iB, vB, kB, dB, 0);
    SCAN_BODY(0, qA, aA, iA, vA, kA, dA, 0);
    for (int c = 1; c + 2 < NCH; c += 2) {
        __builtin_amdgcn_s_waitcnt(SCAN_WAIT);
        if (RW) SCAN_LOADBT(c);
        SCAN_LOAD1(c + 1, qA, aA, iA, vA, kA, dA, 0);
        if (RW) SCAN_BODY(c, qB, aB, iB, vB, kA, dB, 0); else SCAN_BODY(c, qB, aB, iB, vB, kB, dB, 0);
        __builtin_amdgcn_s_waitcnt(SCAN_WAIT);
        if (RW) SCAN_LOADBT(c + 1);
        SCAN_LOAD1(c + 2, qB, aB, iB, vB, kB, dB, 0);
        SCAN_BODY(c + 1, qA, aA, iA, vA, kA, dA, 0);
    }
    asm volatile("" : "+v"(lane)); r = lane & 31; h2 = lane >> 5;
    __builtin_amdgcn_s_waitcnt(SCAN_WAIT);
    if (RW) SCAN_LOADBT(NCH - 2);
    SCAN_LOAD1(NCH - 1, qA, aA, iA, vA, kA, dA, 0);
    if (RW) SCAN_BODY(NCH - 2, qB, aB, iB, vB, kA, dB, 0); else SCAN_BODY(NCH - 2, qB, aB, iB, vB, kB, dB, 0);
    if (RW) SCAN_LOADBT(NCH - 1);
    SCAN_BODY(NCH - 1, qA, aA, iA, vA, kA, dA, 1);
#undef SCAN_LOAD1
#undef SCAN_BODY
#undef SCAN_LOADBT
    if (RW) {
#pragma unroll
        for (int g = 0; g < 4; ++g) { *(f32x4*)(sout + (size_t)r * st_v + 8 * g + 4 * h2) = (f32x4){S0[4 * g], S0[4 * g + 1], S0[4 * g + 2], S0[4 * g + 3]}; *(f32x4*)(sout + (size_t)r * st_v + 32 + 8 * g + 4 * h2) = (f32x4){S1[4 * g], S1[4 * g + 1], S1[4 * g + 2], S1[4 * g + 3]}; }
    } else {
#pragma unroll
        for (int e = 0; e < 16; ++e) { const int k = (e & 3) + 8 * (e >> 2) + 4 * h2; sout[(size_t)k * st_k + (size_t)r * st_v] = S0[e]; sout[(size_t)(k + 32) * st_k + (size_t)r * st_v] = S1[e]; }
    }
}
__device__ __forceinline__ void scan_glr_item(Frame& F, int l, int it) {
    if (it < 128) { const int sl = it & 3, kh = (it >> 2) & 1, h = (it >> 3) & 3, b = it >> 5;
        const int unit = (b * 4 + h) * 2 + kh;
        const unsigned char* ub = F.ws + WS_GU + (size_t)unit * NCH * UBG;
        const unsigned char* uai = kh == 0 ? ub : nullptr;
        const unsigned char* vt = F.ws + WS_GV + ((((size_t)b * 8 + h) * NCH) * 4 + sl) * 2048;
        bf16* ob = (kh == 0 ? WSP(bf16, WS_OH) : WSP(bf16, WS_OH1)) + (size_t)(b * TP) * 512 + h * 128 + sl * 32;
        float* so = F.out + O_HGP + (((size_t)l * NB + b) * 4 + h) * 16384 + (size_t)(64 * kh) * 128 + sl * 32;
        scan_pipe<false>(F, ub, UBG, uai, vt, 4 * 2048, ob, 512, so, 128, 1);
    } else { const int r = it - 128, sl = r & 3, h = (r >> 2) & 3, b = r >> 4;
        const int unit = NU_H + b * 4 + h;
        const unsigned char* ub = F.ws + WS_GU + (size_t)unit * NCH * UBG;
        const unsigned char* vt = F.ws + WS_GV + ((((size_t)b * 8 + 4 + h) * NCH) * 4 + sl) * 2048;
        bf16* ob = WSP(bf16, WS_OG) + (size_t)(b * TP) * 512 + h * 128 + sl * 32;
        float* so = F.out + O_GLP + (((size_t)l * NB + b) * 4 + h) * 8192 + sl * 32;
        scan_pipe<false>(F, ub, UBG, ub, vt, 4 * 2048, ob, 512, so, 128, 1);
    }
}
constexpr size_t RW_LDS_IMG = 0;
constexpr size_t RW_LDS_LOX = 20480;
constexpr size_t RW_LDS_LW = RW_LDS_LOX + 32 * 264 * 2;
constexpr size_t RW_LDS_AA = RW_LDS_LW + 8192;
constexpr size_t RW_LDS_QS = RW_LDS_AA + 8192;
constexpr size_t RW_LDS_GB = RW_LDS_QS + 2048;
constexpr size_t RW_LDS_F32 = RW_LDS_GB + 4 * 32 * 72 * 2;
constexpr size_t RW_LDS_VS = RW_LDS_F32 + 4 * 8192;
constexpr size_t RW_LDS_MM = RW_LDS_LOX;
constexpr size_t RW_LDS_TT = RW_LDS_MM + 4 * 32 * 33 * 4;
constexpr size_t RW_LDS_M1 = RW_LDS_TT + 32 * 33 * 4;
constexpr size_t RW_LDS_AH = RW_LDS_M1 + 32 * 33 * 4;
static_assert(RW_LDS_AH + 8192 <= RW_LDS_GB, "rwkv pre LDS overlay");
constexpr size_t RW_LDS_END = RW_LDS_VS + 8192;
static_assert(RW_LDS_END <= RING_BYTES, "rwkv pre LDS");
__device__ __forceinline__ bf16x8 ldsfrag(const LAS float* p, int cs) {
    union { unsigned u[4]; bf16x8 v; } x;
    x.u[0] = cvtpk(p[0], p[cs]); x.u[1] = cvtpk(p[2 * cs], p[3 * cs]); x.u[2] = cvtpk(p[4 * cs], p[5 * cs]); x.u[3] = cvtpk(p[6 * cs], p[7 * cs]);
    return x.v;
}
__device__ __forceinline__ int lds_s(int x) { asm volatile("" : "+s"(x)); return x; }
__device__ __forceinline__ int lds_v(int x) { asm volatile("" : "+v"(x)); return x; }
__device__ __forceinline__ float fsig(float x) { return __builtin_amdgcn_rcpf(1.f + __expf(-x)); }
__device__ __forceinline__ float ftanh(float x) { return 1.f - 2.f * __builtin_amdgcn_rcpf(1.f + __expf(2.f * x)); }
__device__ __forceinline__ void rwkv_pre_item(Frame& F, int l, int b, int h, int c) {
    LAS unsigned char* L = F.lds + RING_OFF;
    LAS unsigned short* IMG = (LAS unsigned short*)(L + RW_LDS_IMG);
    LAS unsigned short* LOX = (LAS unsigned short*)(L + RW_LDS_LOX);
    LAS float* LW = (LAS float*)(L + RW_LDS_LW); LAS float* AA = (LAS float*)(L + RW_LDS_AA); LAS float* QS = (LAS float*)(L + RW_LDS_QS);
    LAS unsigned short* GB = (LAS unsigned short*)(L + RW_LDS_GB);
    LAS float* AF = (LAS float*)(L + RW_LDS_F32); LAS float* RF = AF + 2048; LAS float* BPF = RF + 2048; LAS float* KPF = BPF + 2048;
    LAS float* VS = (LAS float*)(L + RW_LDS_VS); LAS float* MM = (LAS float*)(L + RW_LDS_MM); LAS float* TT = (LAS float*)(L + RW_LDS_TT); LAS float* M1 = (LAS float*)(L + RW_LDS_M1); LAS float* AH = (LAS float*)(L + RW_LDS_AH);
    const bf16* P = WSP(bf16, WS_P); const float* mu = GIN(13) + (size_t)l * RC;
    const int t0 = 32 * c; const size_t rowb = (size_t)b * TP;
    unsigned short cR[4], cK[4], cV[4], pR[4], pK[4], pV[4];
    { const int k_ = F.lane, tq_ = F.wave, col_ = h * 64 + k_;
#pragma unroll
      for (int i = 0; i < 4; ++i) { const int t = t0 + 4 * tq_ + i; const bf16* p = P + (rowb + (t < TP ? t : 0)) * INP;
          cR[i] = p[col_]; cK[i] = p[512 + col_]; cV[i] = p[1024 + col_];
          pR[i] = t > 0 ? p[col_ - INP] : (unsigned short)0; pK[i] = t > 0 ? p[512 + col_ - INP] : (unsigned short)0; pV[i] = t > 0 ? p[1024 + col_ - INP] : (unsigned short)0; } }
    __syncthreads();
    for (int idx = F.tid; idx < 32 * 256; idx += NTHR) {
        const int tt = idx >> 8, col = idx & 255, t = t0 + tt; const int pc = 1536 + col;
        float v = 0.f;
        if (t < TP) { const bf16* p = P + (rowb + t) * INP; const float cur = bf2f(p[pc]); const float prev = t > 0 ? bf2f(p[pc - INP]) : 0.f; const float x = cur + (prev - cur) * mu[pc];
            v = col < 64 ? ftanh(x) : (col < 128 ? x : fsig(x)); }
        LOX[tt * 264 + col] = (unsigned short)f2bf(v);
    }
    __syncthreads();
    if (F.wave < 6) {
        const int wv_ = lds_s(F.wave), ln_ = lds_v(F.lane);
        const int qn = wv_ >> 1, nt = wv_ & 1, r = ln_ & 31, h2 = ln_ >> 5;
        const int kw = qn == 2 ? 128 : 64, ko = qn == 0 ? 0 : (qn == 1 ? 64 : 128);
        const bf16* WT = qn == 0 ? WSP(bf16, WS_WUPT) + (size_t)l * 512 * 64 : (qn == 1 ? WSP(bf16, WS_AUPT) + (size_t)l * 512 * 64 : WSP(bf16, WS_GUPT) + (size_t)l * 512 * 128);
        const int col = h * 64 + 32 * nt + r;
        f32x16 acc;
#pragma unroll
        for (int e = 0; e < 16; ++e) acc[e] = 0.f;
        for (int s = 0; s < kw / 16; ++s) {
            const bf16x8 af = *(const LAS bf16x8*)(LOX + r * 264 + ko + 16 * s + 8 * h2);
            const bf16x8 bf = *(const bf16x8*)(WT + (size_t)col * kw + 16 * s + 8 * h2);
            acc = __builtin_amdgcn_mfma_f32_32x32x16_bf16(af, bf, acc, 0, 0, 0);
        }
        const float c0 = qn == 0 ? GIN(14)[(size_t)l * 512 + col] : (qn == 1 ? GIN(16)[(size_t)l * 512 + col] : 0.f);
        bf16* GBUF = WSP(bf16, WS_RG);
#pragma unroll
        for (int e = 0; e < 16; ++e) { const int tt = (e & 3) + 8 * (e >> 2) + 4 * h2; const float x = acc[e] + c0;
            if (qn == 0) LW[tt * 64 + 32 * nt + r] = -0.606531f * fsig(x);
            else if (qn == 1) AA[tt * 64 + 32 * nt + r] = fsig(x);
            else if (t0 + tt < TP) GBUF[(rowb + t0 + tt) * 512 + col] = (bf16)f2bf(x); }
    }
    __syncthreads();
    const int k = lds_v(F.lane), tq = lds_s(F.wave), col = h * 64 + k;
    float lwv[4], cin[4], rr[4], km[4], kkv[4], kav[4], vv[4];
    { const float kkw = GIN(19)[(size_t)l * 512 + col], kaw = GIN(20)[(size_t)l * 512 + col], rkw = GIN(21)[(size_t)l * 512 + col];
      const float mur = mu[col], muk = mu[512 + col], muv = mu[1024 + col];
      float* BV = WSP(float, WS_RBV);
      float run = 0.f;
#pragma unroll
      for (int i = 0; i < 4; ++i) {
          const int tt = 4 * tq + i, t = t0 + tt; const bool ok = t < TP;
          const float cr = bf2f(cR[i]), ck = bf2f(cK[i]), cv = bf2f(cV[i]);
          const float pr = bf2f(pR[i]), pk = bf2f(pK[i]), pv = bf2f(pV[i]);
          float r_ = cr + (pr - cr) * mur, k_ = ck + (pk - ck) * muk, v_ = cv + (pv - cv) * muv;
          const float a_ = AA[tt * 64 + k]; float lw_ = LW[tt * 64 + k];
          float kk_ = k_ * kkw;
          const float nrm = fmaxf(sqrtf(wave_sum(kk_ * kk_)), 1e-12f);
          kk_ = kk_ / nrm;
          float kmod = k_ * (1.f + (a_ - 1.f) * kaw);
          if (!ok) { r_ = 0.f; kmod = 0.f; v_ = 0.f; kk_ = 0.f; lw_ = 0.f; }
          const float bonus = wave_sum(r_ * kmod * rkw);
          if (ok) BV[(rowb + t) * 512 + col] = bonus * v_;
          run += lw_; lwv[i] = lw_; cin[i] = run; rr[i] = r_; km[i] = kmod; kkv[i] = kk_; kav[i] = kk_ * a_; vv[i] = v_;
      }
      QS[tq * 64 + k] = run;
    }
    __syncthreads();
    float c31 = 0.f, pre = 0.f;
#pragma unroll
    for (int q2 = 0; q2 < 8; ++q2) { const float x = QS[q2 * 64 + k]; c31 += x; if (q2 < tq) pre += x; }
#pragma unroll
    for (int i = 0; i < 4; ++i) {
        const int tt = 4 * tq + i; const float ci = cin[i] + pre, ce = ci - lwv[i];
        const float en = __expf(-ci), ep = __expf(c31 - ci);
        const float a_i = __expf(ce) * kkv[i], b_i = kav[i] * en, kt_i = km[i] * en, rt_i = rr[i] * __expf(ci), bp_i = kav[i] * ep, kp_i = km[i] * ep;
        GB[(0 * 32 + tt) * 72 + k] = (unsigned short)f2bf(b_i); GB[(1 * 32 + tt) * 72 + k] = (unsigned short)f2bf(kt_i);
        GB[(2 * 32 + tt) * 72 + k] = (unsigned short)f2bf(a_i); GB[(3 * 32 + tt) * 72 + k] = (unsigned short)f2bf(rt_i);
        AF[tt * 64 + k] = a_i; RF[tt * 64 + k] = rt_i; BPF[tt * 64 + k] = bp_i; KPF[tt * 64 + k] = kp_i; VS[tt * 64 + k] = vv[i];
    }
    if (tq == 0) ((LAS float*)(IMG + UB_DT / 2))[k] = expf(c31);
    __syncthreads();
    if (F.tid < 256) { const int v = F.tid & 63, q = F.tid >> 6; unsigned w[4];
#pragma unroll
        for (int i = 0; i < 8; i += 2) w[i >> 1] = pk2(VS[(8 * q + i) * 64 + v], VS[(8 * q + i + 1) * 64 + v]);
        unsigned char* vt = F.ws + WS_RV + ((((size_t)b * 8 + h) * NCH + c) * 2 + (v >> 5)) * 2048;
        *(v4u*)(vt + (((q >> 1) * 2 + (q & 1)) * 32 + (v & 31)) * 16) = (v4u){w[0], w[1], w[2], w[3]}; }
    if (F.wave < 4) {
        const int wv_ = lds_s(F.wave), ln_ = lds_v(F.lane);
        const int rs = wv_ >> 1, cs = wv_ & 1, r = ln_ & 31, h2 = ln_ >> 5;
        f32x16 acc;
#pragma unroll
        for (int e = 0; e < 16; ++e) acc[e] = 0.f;
#pragma unroll
        for (int s = 0; s < 4; ++s) {
            const bf16x8 af = *(const LAS bf16x8*)(GB + (rs * 32 + r) * 72 + 16 * s + 8 * h2);
            const bf16x8 bf = *(const LAS bf16x8*)(GB + ((2 + cs) * 32 + r) * 72 + 16 * s + 8 * h2);
            acc = __builtin_amdgcn_mfma_f32_32x32x16_bf16(af, bf, acc, 0, 0, 0);
        }
#pragma unroll
        for (int e = 0; e < 16; ++e) { const int j = (e & 3) + 8 * (e >> 2) + 4 * h2, i = r; const bool keep = cs ? (j <= i) : (j < i); MM[(wv_ * 32 + j) * 33 + i] = keep ? acc[e] : 0.f; }
    }
    __syncthreads();
    const LAS float* Mba = MM; const LAS float* Mbr = MM + 32 * 33; const LAS float* Mka = MM + 2 * 32 * 33; const LAS float* Mkr = MM + 3 * 32 * 33;
    if (F.wave == 0 && F.lane < 32) {
        const int ln_ = lds_v(F.lane);
        const int i = ln_ & 15, base = ln_ & 16; float t[16];
#pragma unroll
        for (int j = 15; j >= 0; --j) { float acc = (j == i) ? 1.f : 0.f;
#pragma unroll
            for (int m = j + 1; m < 16; ++m) acc -= Mba[(base + j) * 33 + base + m] * t[m];
            t[j] = acc; }
#pragma unroll
        for (int j = 0; j < 16; ++j) { TT[(base + j) * 33 + base + i] = t[j]; if (base == 0) TT[(16 + j) * 33 + i] = 0.f; }
    }
    __syncthreads();
    if (F.tid < 256) { const int j = F.tid >> 4, i = F.tid & 15; float sacc = 0.f;
#pragma unroll
        for (int m = 0; m < 16; ++m) sacc += Mba[j * 33 + 16 + m] * TT[(16 + m) * 33 + 16 + i];
        M1[j * 16 + i] = sacc; }
    __syncthreads();
    if (F.tid < 256) { const int j = F.tid >> 4, i = F.tid & 15; float sacc = 0.f;
#pragma unroll
        for (int m = 0; m < 16; ++m) sacc -= TT[j * 33 + m] * M1[m * 16 + i];
        TT[j * 33 + 16 + i] = sacc; }
    __syncthreads();
    { const int ln_ = lds_v(F.lane), wv_ = lds_s(F.wave); const int r = ln_ & 31, h2 = ln_ >> 5;
      if (wv_ == 0) { f32x16 acc;
#pragma unroll
          for (int e = 0; e < 16; ++e) acc[e] = 0.f;
#pragma unroll
          for (int s2 = 0; s2 < 2; ++s2) acc = __builtin_amdgcn_mfma_f32_32x32x16_bf16(ldsfrag(Mka + r * 33 + 16 * s2 + 8 * h2, 1), ldsfrag(TT + (16 * s2 + 8 * h2) * 33 + r, 33), acc, 0, 0, 0);
#pragma unroll
          for (int e = 0; e < 16; ++e) M1[((e & 3) + 8 * (e >> 2) + 4 * h2) * 33 + r] = acc[e];
      } else if (wv_ < 3) { const int nt = wv_ - 1, kk2 = 32 * nt + r; f32x16 acc;
#pragma unroll
          for (int e = 0; e < 16; ++e) acc[e] = 0.f;
#pragma unroll
          for (int s2 = 0; s2 < 2; ++s2) acc = __builtin_amdgcn_mfma_f32_32x32x16_bf16(ldsfrag(TT + (16 * s2 + 8 * h2) * 33 + r, 33), ldsfrag(AF + (16 * s2 + 8 * h2) * 64 + kk2, 64), acc, 0, 0, 0);
          const int s = kk2 >> 4, hp = (kk2 >> 2) & 1, jp = ((kk2 >> 3) & 1) * 4 + (kk2 & 3);
#pragma unroll
          for (int e = 0; e < 16; ++e) { const int i = (e & 3) + 8 * (e >> 2) + 4 * h2; AH[i * 64 + kk2] = acc[e]; IMG[(UB_AT + ((s * 2 + hp) * 32 + i) * 16 + jp * 2) / 2] = (unsigned short)f2bf(acc[e]); }
      }
    }
    __syncthreads();
    { const int ln_ = lds_v(F.lane), wv_ = lds_s(F.wave); const int r = ln_ & 31, h2 = ln_ >> 5;
      if (wv_ == 0) { f32x16 acc;
#pragma unroll
          for (int e = 0; e < 16; ++e) acc[e] = 0.f;
#pragma unroll
          for (int s2 = 0; s2 < 2; ++s2) acc = __builtin_amdgcn_mfma_f32_32x32x16_bf16(ldsfrag(M1 + r * 33 + 16 * s2 + 8 * h2, 1), ldsfrag(Mbr + (16 * s2 + 8 * h2) * 33 + r, 33), acc, 0, 0, 0);
#pragma unroll
          for (int e = 0; e < 16; ++e) { const int j = (e & 3) + 8 * (e >> 2) + 4 * h2, i = r; const float v = Mkr[j * 33 + i] - acc[e];
              IMG[(UB_AI + (((j >> 4) * 2 + ((j >> 3) & 1)) * 32 + i) * 16 + (j & 7) * 2) / 2] = (unsigned short)f2bf(v); }
      } else if (wv_ < 3) { const int nt = wv_ - 1, kk2 = 32 * nt + r; f32x16 acc;
#pragma unroll
          for (int e = 0; e < 16; ++e) acc[e] = 0.f;
#pragma unroll
          for (int s2 = 0; s2 < 2; ++s2) acc = __builtin_amdgcn_mfma_f32_32x32x16_bf16(ldsfrag(Mbr + (16 * s2 + 8 * h2) * 33 + r, 33), ldsfrag(AH + (16 * s2 + 8 * h2) * 64 + kk2, 64), acc, 0, 0, 0);
          const int s = kk2 >> 4, hp = (kk2 >> 2) & 1, jp = ((kk2 >> 3) & 1) * 4 + (kk2 & 3);
#pragma unroll
          for (int e = 0; e < 16; ++e) { const int i = (e & 3) + 8 * (e >> 2) + 4 * h2; IMG[(UB_QT + ((s * 2 + hp) * 32 + i) * 16 + jp * 2) / 2] = (unsigned short)f2bf(RF[i * 64 + kk2] - acc[e]); }
      } else if (wv_ < 5) { const int nt = wv_ - 3, kk2 = 32 * nt + r; f32x16 acc;
#pragma unroll
          for (int e = 0; e < 16; ++e) acc[e] = 0.f;
#pragma unroll
          for (int s2 = 0; s2 < 2; ++s2) acc = __builtin_amdgcn_mfma_f32_32x32x16_bf16(ldsfrag(M1 + r * 33 + 16 * s2 + 8 * h2, 1), ldsfrag(BPF + (16 * s2 + 8 * h2) * 64 + kk2, 64), acc, 0, 0, 0);
          const int m = kk2 >> 5, rr2 = kk2 & 31;
#pragma unroll
          for (int e = 0; e < 16; ++e) { const int j = (e & 3) + 8 * (e >> 2) + 4 * h2; IMG[(UB_KT + (((m * 2 + (j >> 4)) * 2 + ((j >> 3) & 1)) * 32 + rr2) * 16 + (j & 7) * 2) / 2] = (unsigned short)f2bf(KPF[j * 64 + kk2] - acc[e]); }
      } else { for (int o = lds_v(F.tid) - 320; o < 2048; o += 192) { const int i = o >> 6, kk2 = o & 63, m = kk2 >> 5, rr2 = kk2 & 31, w = i & 15, ep = ((w >> 3) & 1) * 4 + (w & 3), hq = (w >> 2) & 1;
              IMG[(UB_BT + (((m * 2 + (i >> 4)) * 2 + hq) * 32 + rr2) * 16 + ep * 2) / 2] = (unsigned short)f2bf(BPF[i * 64 + kk2]); } }
    }
    __syncthreads();
    { unsigned char* ub = F.ws + WS_RU + (((size_t)b * 8 + h) * NCH + c) * UBR;
      for (int o = F.tid; o < UBR / 16; o += NTHR) *(v4u*)(ub + o * 16) = *(const LAS v4u*)(L + RW_LDS_IMG + o * 16); }
}
__device__ __forceinline__ void rwkv_pre(Frame& F, int l) {
    for (int it = blockIdx.x; it < NB * 8 * NCH; it += F.G) { const int c = it % NCH, bh = it / NCH; rwkv_pre_item(F, l, bh >> 3, bh & 7, c); }
    __syncthreads();
}
__device__ __forceinline__ void scan_rwkv_chunked(Frame& F, int l, int b, int h, int sl) {
    const unsigned char* ub = F.ws + WS_RU + (((size_t)b * 8 + h) * NCH) * UBR;
    const unsigned char* vt = F.ws + WS_RV + ((((size_t)b * 8 + h) * NCH) * 2 + sl) * 2048;
    bf16* obuf = WSP(bf16, WS_RY) + (size_t)(b * TP) * 512 + h * 64 + sl * 32;
    float* so = F.out + O_RWP + ((((size_t)l * NB + b) * 8 + h) * 64 + sl * 32) * 64;
    scan_pipe<true>(F, ub, UBR, ub, vt, 2 * 2048, obuf, 512, so, 1, 64);
}
__device__ __forceinline__ void unpack8(const v4u a, float (&o)[8]);
__device__ __forceinline__ bf16x8 pack8f(const float (&v)[8]) { union { unsigned u[4]; bf16x8 x; } q; q.u[0] = cvtpk(v[0], v[1]); q.u[1] = cvtpk(v[2], v[3]); q.u[2] = cvtpk(v[4], v[5]); q.u[3] = cvtpk(v[6], v[7]); return q.x; }
__device__ __forceinline__ bf16x8 u4frag(const unsigned (&u)[4]) { union { unsigned w[4]; bf16x8 x; } q; q.w[0] = u[0]; q.w[1] = u[1]; q.w[2] = u[2]; q.w[3] = u[3]; return q.x; }
__device__ __forceinline__ f32x16 negt(const f32x16& a) { f32x16 o;
#pragma unroll
    for (int e = 0; e < 16; ++e) o[e] = -a[e];
    return o; }
__device__ __forceinline__ float half_sum(float v) { v += __shfl_xor(v, 1); v += __shfl_xor(v, 2); v += __shfl_xor(v, 4); v += __shfl_xor(v, 8); v += __shfl_xor(v, 16); return v; }
template <int STAGE, int WMASK = 31>
__device__ __forceinline__ void rwkv_pre_wave(Frame& F, int l, int b, int h, int c) {
    LAS unsigned char* L = F.lds + RING_OFF + F.wave * 16384;
    const int lane = F.lane, r = lane & 31, h2 = lane >> 5;
    const bf16* P = WSP(bf16, WS_P); const float* mu = GIN(13) + (size_t)l * RC;
    const int t0 = 32 * c; const size_t rowb = (size_t)b * TP;
    unsigned char* ub = F.ws + WS_RU + (((size_t)b * 8 + h) * NCH + c) * UBR;
#define TAU(e) (((e) & 3) + 8 * ((e) >> 2) + 4 * h2)
    static_assert(TP - 32 * (NCH - 1) == 16, "the last chunk holds 16 tokens");
    const bool lastc = (c == NCH - 1);
#define OKE(e) (!lastc || (e) < 8)
    f32x16 lw[2], av[2];
    { f32x16 aw[2], aa[2], ag[2];
#pragma unroll
      for (int nt = 0; nt < 2; ++nt)
#pragma unroll
          for (int e = 0; e < 16; ++e) { aw[nt][e] = 0.f; aa[nt][e] = 0.f; ag[nt][e] = 0.f; }
      const int tok = t0 + r; const bool tv = !lastc || r < 16; const bf16* prow = P + (rowb + (tv ? tok : 0)) * INP;
      const bf16* WU = WSP(bf16, WS_WUPT) + ((size_t)l * 512 + h * 64 + r) * 64; const bf16* AU = WSP(bf16, WS_AUPT) + ((size_t)l * 512 + h * 64 + r) * 64; const bf16* GU = WSP(bf16, WS_GUPT) + ((size_t)l * 512 + h * 64 + r) * 128;
#pragma unroll
      for (int s = 0; s < 16; ++s) {
          const int pc = 1536 + 16 * s + 8 * h2;
          float x[8]; { float cu[8], pv[8]; unpack8(*(const v4u*)(prow + pc), cu);
              if (tok > 0) unpack8(*(const v4u*)(prow + pc - INP), pv); else {
#pragma unroll
                  for (int j = 0; j < 8; ++j) pv[j] = 0.f; }
              const f32x4 m0 = *(const f32x4*)(mu + pc), m1 = *(const f32x4*)(mu + pc + 4); const float mm[8] = {m0.x, m0.y, m0.z, m0.w, m1.x, m1.y, m1.z, m1.w};
#pragma unroll
              for (int j = 0; j < 8; ++j) { const float y = cu[j] + (pv[j] - cu[j]) * mm[j]; x[j] = tv ? (s < 4 ? ftanh(y) : (s < 8 ? y : fsig(y))) : 0.f; } }
          const bf16x8 af = pack8f(x);
#pragma unroll
          for (int nt = 0; nt < 2; ++nt) {
              if (s < 4) aw[nt] = MF32(af, *(const bf16x8*)(WU + (size_t)(32 * nt) * 64 + 16 * s + 8 * h2), aw[nt]);
              else if (s < 8) aa[nt] = MF32(af, *(const bf16x8*)(AU + (size_t)(32 * nt) * 64 + 16 * (s - 4) + 8 * h2), aa[nt]);
              else ag[nt] = MF32(af, *(const bf16x8*)(GU + (size_t)(32 * nt) * 128 + 16 * (s - 8) + 8 * h2), ag[nt]);
          }
          if ((s & 3) == 3) __builtin_amdgcn_sched_barrier(0);
      }
      bf16* gb = WSP(bf16, WS_RG) + (rowb + t0 + 4 * h2) * 512 + h * 64 + r;
#pragma unroll
      for (int nt = 0; nt < 2; ++nt) { const int col = h * 64 + 32 * nt + r; const float w0c = GIN(14)[(size_t)l * 512 + col], a0c = GIN(16)[(size_t)l * 512 + col];
#pragma unroll
          for (int e = 0; e < 16; ++e) { lw[nt][e] = -0.606531f * fsig(aw[nt][e] + w0c); av[nt][e] = fsig(aa[nt][e] + a0c);
              if (OKE(e)) gb[((e & 3) + 8 * (e >> 2)) * 512 + 32 * nt] = (bf16)f2bf(ag[nt][e]); } }
    }
    __builtin_amdgcn_sched_barrier(0);
    float pre[2][4], c31[2];
#pragma unroll
    for (int nt = 0; nt < 2; ++nt) { float qs[4], pq[4];
#pragma unroll
        for (int g = 0; g < 4; ++g) { float run = 0.f;
#pragma unroll
            for (int i = 0; i < 4; ++i) { if (!OKE(4 * g + i)) lw[nt][4 * g + i] = 0.f; run += lw[nt][4 * g + i]; }
            qs[g] = run; pq[g] = __shfl_xor(run, 32); }
        float run = 0.f;
#pragma unroll
        for (int g = 0; g < 4; ++g) { pre[nt][g] = run + (h2 ? pq[g] : 0.f); run += qs[g] + pq[g]; }
        c31[nt] = run; }
    LAS unsigned short* PS = (LAS unsigned short*)L;
    asm volatile("" ::: "memory");
    for (int idx = lane; idx < 33 * 24; idx += 64) { const int i = idx / 24, p = idx % 24, tk = t0 - 1 + i;
        v4u v = {0u, 0u, 0u, 0u}; if (tk >= 0 && tk < TP) v = *(const v4u*)(P + (rowb + tk) * INP + (p >> 3) * 512 + h * 64 + (p & 7) * 8);
        *(LAS v4u*)(PS + i * 200 + (p >> 3) * 64 + (p & 7) * 8) = v; }
    LDS_WAIT(); asm volatile("" ::: "memory");
    float mur[2], muk[2], muv[2], kkw[2], kaw[2], rkw[2];
#pragma unroll
    for (int nt = 0; nt < 2; ++nt) { const int col = h * 64 + 32 * nt + r; mur[nt] = mu[col]; muk[nt] = mu[512 + col]; muv[nt] = mu[1024 + col];
        kkw[nt] = GIN(19)[(size_t)l * 512 + col]; kaw[nt] = GIN(20)[(size_t)l * 512 + col]; rkw[nt] = GIN(21)[(size_t)l * 512 + col]; }
    float inv[16];
    { bf16* bvp = WSP(bf16, WS_RBV) + (rowb + t0 + 4 * h2) * 512 + h * 64 + r;
#pragma unroll
      for (int e = 0; e < 16; ++e) { float n2 = 0.f, bo = 0.f, v2[2];
#pragma unroll
          for (int nt = 0; nt < 2; ++nt) { const LAS unsigned short* q = PS + (1 + TAU(e)) * 200 + 32 * nt + r;
              const float cr = bf2f(q[0]), ck = bf2f(q[64]), cv = bf2f(q[128]), pr = bf2f(q[-200]), pk = bf2f(q[-200 + 64]), pv = bf2f(q[-200 + 128]);
              const float r_ = cr + (pr - cr) * mur[nt], k_ = ck + (pk - ck) * muk[nt], kr = k_ * kkw[nt], kmod = k_ * (1.f + (av[nt][e] - 1.f) * kaw[nt]);
              v2[nt] = cv + (pv - cv) * muv[nt];
              if (OKE(e)) { n2 += kr * kr; bo += r_ * kmod * rkw[nt]; } }
          inv[e] = __builtin_amdgcn_rsqf(fmaxf(half_sum(n2), 1e-24f));        const float bon = half_sum(bo);
          if (OKE(e)) { bvp[((e & 3) + 8 * (e >> 2)) * 512] = (bf16)f2bf(bon * v2[0]); bvp[((e & 3) + 8 * (e >> 2)) * 512 + 32] = (bf16)f2bf(bon * v2[1]); }
          __builtin_amdgcn_sched_barrier(0); } }
    unsigned char* scr = F.ws + WS_RSCR + (size_t)(F.gw & 2047) * 20480 + lane * 16;
#define SCRF(mat, nt, hf) (*(bf16x8*)(scr + (((mat) * 2 + (nt)) * 2 + (hf)) * 1024))
#define BTF(nt, hf) (*(bf16x8*)(ub + UB_BT + (((nt) * 2 + (hf)) * 64 + lane) * 16))
#pragma unroll
    for (int nt = 0; nt < 2; ++nt) {
        unsigned char* vt = F.ws + WS_RV + ((((size_t)b * 8 + h) * NCH + c) * 2 + nt) * 2048;
#pragma unroll
        for (int hf = 0; hf < 2; ++hf) { unsigned au[4], bu[4], ku[4], ru[4], pu[4], qu[4], vu[4];
#pragma unroll
            for (int g2 = 0; g2 < 2; ++g2) { float run = pre[nt][2 * hf + g2];
#pragma unroll
                for (int i2 = 0; i2 < 2; ++i2) { float a2[2], b2[2], k2[2], r2[2], p2[2], q2[2], v2[2];
#pragma unroll
                    for (int i1 = 0; i1 < 2; ++i1) { const int i = 2 * i2 + i1, j = 4 * g2 + i, e = 8 * hf + j; const bool ok = OKE(e);
                        run += lw[nt][e]; const float ci = run;
                        const LAS unsigned short* q = PS + (1 + TAU(e)) * 200 + 32 * nt + r;
                        const float cr = bf2f(q[0]), ck = bf2f(q[64]), cv = bf2f(q[128]), pr = bf2f(q[-200]), pk = bf2f(q[-200 + 64]), pv = bf2f(q[-200 + 128]);
                        float r_ = cr + (pr - cr) * mur[nt], k_ = ck + (pk - ck) * muk[nt], v_ = cv + (pv - cv) * muv[nt];
                        float kkn = k_ * kkw[nt] * inv[e], kmod = k_ * (1.f + (av[nt][e] - 1.f) * kaw[nt]);
                        if (!ok) { r_ = 0.f; kmod = 0.f; v_ = 0.f; kkn = 0.f; }
                        const float ka = kkn * av[nt][e], en = __expf(-ci), e31 = __expf(c31[nt] - ci);
                        a2[i1] = __expf(ci - lw[nt][e]) * kkn; b2[i1] = ka * en; k2[i1] = kmod * en; r2[i1] = r_ * __expf(ci); p2[i1] = ka * e31; q2[i1] = kmod * e31; v2[i1] = v_; }
                    const int w = 2 * g2 + i2;
                    au[w] = cvtpk(a2[0], a2[1]); bu[w] = cvtpk(b2[0], b2[1]); ku[w] = cvtpk(k2[0], k2[1]); ru[w] = cvtpk(r2[0], r2[1]); pu[w] = cvtpk(p2[0], p2[1]); qu[w] = cvtpk(q2[0], q2[1]); vu[w] = cvtpk(v2[0], v2[1]);
                    __builtin_amdgcn_sched_barrier(0); } }
            SCRF(0, nt, hf) = u4frag(au); SCRF(1, nt, hf) = u4frag(bu); SCRF(2, nt, hf) = u4frag(ku); SCRF(3, nt, hf) = u4frag(ru); SCRF(4, nt, hf) = u4frag(qu);
            if (STAGE >= 2 && (WMASK & 1)) *(bf16x8*)(vt + (hf * 64 + lane) * 16) = u4frag(vu);
            BTF(nt, hf) = u4frag(pu);
            __builtin_amdgcn_sched_barrier(0); }
        if (h2 == 0) *(float*)(ub + UB_DT + (32 * nt + r) * 4) = __expf(c31[nt]);
    }
    if (STAGE < 2) return;
    asm volatile("s_waitcnt vmcnt(0)" ::: "memory");
    __builtin_amdgcn_sched_barrier(0);
    bf16x8 I0, I1;
    { float x0[8], x1[8];
#pragma unroll
      for (int j = 0; j < 8; ++j) { const int m = 8 * (j >> 2) + 4 * h2 + (j & 3); x0[j] = (m == r) ? 1.f : 0.f; x1[j] = (16 + m == r) ? 1.f : 0.f; }
      I0 = pack8f(x0); I1 = pack8f(x1); }
    bf16x8 fB[4], fA[4], fK[4], fR[4];
#pragma unroll
#define TLFRAGS(MAT, FO) do { _Pragma("unroll") for (int nt = 0; nt < 2; ++nt) { f32x16 tt_; _Pragma("unroll") for (int e = 0; e < 16; ++e) tt_[e] = 0.f; \
        tt_ = MF32(SCRF(MAT, nt, 0), I0, tt_); tt_ = MF32(SCRF(MAT, nt, 1), I1, tt_); FO[2 * nt] = acc2frag(tt_, 0); FO[2 * nt + 1] = acc2frag(tt_, 1); } __builtin_amdgcn_sched_barrier(0); } while (0)
    TLFRAGS(1, fB); TLFRAGS(0, fA); TLFRAGS(2, fK); TLFRAGS(3, fR);
#undef TLFRAGS
    __builtin_amdgcn_sched_barrier(0);
    f32x16 Mba, Mbr, X1, Mkr;
#pragma unroll
    for (int e = 0; e < 16; ++e) { Mba[e] = 0.f; Mbr[e] = 0.f; X1[e] = 0.f; Mkr[e] = 0.f; }
#pragma unroll
    for (int s = 0; s < 4; ++s) { Mba = MF32(fB[s], fA[s], Mba); Mbr = MF32(fB[s], fR[s], Mbr); X1 = MF32(fA[s], fK[s], X1); Mkr = MF32(fK[s], fR[s], Mkr); }
    LAS float* NL = (LAS float*)L; LAS float* TT = NL + 32 * 33; LAS float* PX = TT + 32 * 33;
    asm volatile("" ::: "memory");
#pragma unroll
    for (int e = 0; e < 16; ++e) { const int tj = TAU(e);
        Mba[e] = tj < r ? Mba[e] : 0.f; Mbr[e] = tj <= r ? Mbr[e] : 0.f; Mkr[e] = tj <= r ? Mkr[e] : 0.f; X1[e] = r < tj ? X1[e] : 0.f;
        NL[tj * 33 + r] = Mba[e]; }
    LDS_WAIT(); asm volatile("" ::: "memory");
    __builtin_amdgcn_sched_barrier(0);
    { const int i = lane & 15, base = lane & 16; float t[16];
#pragma unroll
      for (int j = 15; j >= 0; --j) { float acc = (j == i) ? 1.f : 0.f;
#pragma unroll
          for (int m = j + 1; m < 16; ++m) acc -= NL[(base + j) * 33 + base + m] * t[m];
          t[j] = acc; }
#pragma unroll
      for (int j = 0; j < 16; ++j) { TT[(base + j) * 33 + base + i] = t[j]; if (base == 0) TT[(16 + j) * 33 + i] = 0.f; }
      LDS_WAIT(); asm volatile("" ::: "memory");
#pragma unroll
      for (int q = 0; q < 4; ++q) { const int o = lane * 4 + q, j = o >> 4, i2 = o & 15; float sacc = 0.f;
#pragma unroll
          for (int m = 0; m < 16; ++m) sacc += NL[j * 33 + 16 + m] * TT[(16 + m) * 33 + 16 + i2];
          PX[j * 16 + i2] = sacc; }
      LDS_WAIT(); asm volatile("" ::: "memory");
#pragma unroll
      for (int q = 0; q < 4; ++q) { const int o = lane * 4 + q, j = o >> 4, i2 = o & 15; float sacc = 0.f;
#pragma unroll
          for (int m = 0; m < 16; ++m) sacc -= TT[j * 33 + m] * PX[m * 16 + i2];
          TT[j * 33 + 16 + i2] = sacc; }
      LDS_WAIT(); asm volatile("" ::: "memory");
    }
    bf16x8 tF[2], trF[2];
#pragma unroll
    for (int s = 0; s < 2; ++s) { float x[8], y[8];
#pragma unroll
        for (int j = 0; j < 8; ++j) { const int m = 16 * s + 8 * (j >> 2) + 4 * h2 + (j & 3); x[j] = TT[m * 33 + r]; y[j] = TT[r * 33 + m]; }
        tF[s] = pack8f(x); trF[s] = pack8f(y); }
    LDS_WAIT(); asm volatile("" ::: "memory");
    __builtin_amdgcn_sched_barrier(0);
    f32x16 Y, W, M2 = Mkr;
#pragma unroll
    for (int e = 0; e < 16; ++e) { Y[e] = 0.f; W[e] = 0.f; }
    Y = MF32(tF[0], acc2frag(X1, 0), Y); Y = MF32(tF[1], acc2frag(X1, 1), Y);
    const bf16x8 mb0 = acc2frag(Mbr, 0), mb1 = acc2frag(Mbr, 1);
    W = MF32(trF[0], mb0, W); W = MF32(trF[1], mb1, W);
    __builtin_amdgcn_sched_barrier(0);
    const f32x16 Yn = negt(Y), Wn = negt(W);
    const bf16x8 yn0 = acc2frag(Yn, 0), yn1 = acc2frag(Yn, 1), wn0 = acc2frag(Wn, 0), wn1 = acc2frag(Wn, 1);
    M2 = MF32(yn0, mb0, M2); M2 = MF32(yn1, mb1, M2);
    if (WMASK & 2) { *(bf16x8*)(ub + UB_AI + lane * 16) = acc2frag(M2, 0); *(bf16x8*)(ub + UB_AI + (64 + lane) * 16) = acc2frag(M2, 1); }
    __builtin_amdgcn_sched_barrier(0);
#pragma unroll
    for (int nt = 0; nt < 2; ++nt) {
        f32x16 Ah, Rh, Gt, Rt2;
#pragma unroll
        for (int e = 0; e < 16; ++e) { Ah[e] = 0.f; Rh[e] = 0.f; Gt[e] = 0.f; Rt2[e] = 0.f; }
        const bf16x8 a0_ = SCRF(0, nt, 0), a1_ = SCRF(0, nt, 1);
        Ah = MF32(a0_, tF[0], Ah); Ah = MF32(a1_, tF[1], Ah);
        if (WMASK & 16) { *(bf16x8*)(ub + UB_AT + ((2 * nt + 0) * 64 + lane) * 16) = acc2frag(Ah, 0); *(bf16x8*)(ub + UB_AT + ((2 * nt + 1) * 64 + lane) * 16) = acc2frag(Ah, 1); }
        __builtin_amdgcn_sched_barrier(0);
        Rh = MF32(I0, SCRF(3, nt, 0), Rh); Rh = MF32(I1, SCRF(3, nt, 1), Rh); Rh = MF32(wn0, a0_, Rh); Rh = MF32(wn1, a1_, Rh);
        __builtin_amdgcn_sched_barrier(0);
        Gt = MF32(I0, SCRF(4, nt, 0), Gt); Gt = MF32(I1, SCRF(4, nt, 1), Gt); Gt = MF32(yn0, BTF(nt, 0), Gt); Gt = MF32(yn1, BTF(nt, 1), Gt);
        if (WMASK & 4) { *(bf16x8*)(ub + UB_KT + ((nt * 2 + 0) * 64 + lane) * 16) = acc2frag(Gt, 0); *(bf16x8*)(ub + UB_KT + ((nt * 2 + 1) * 64 + lane) * 16) = acc2frag(Gt, 1); }
        __builtin_amdgcn_sched_barrier(0);
        Rt2 = MF32(acc2frag(Rh, 0), I0, Rt2); Rt2 = MF32(acc2frag(Rh, 1), I1, Rt2);
        if (WMASK & 8) { *(bf16x8*)(ub + UB_QT + ((2 * nt + 0) * 64 + lane) * 16) = acc2frag(Rt2, 0); *(bf16x8*)(ub + UB_QT + ((2 * nt + 1) * 64 + lane) * 16) = acc2frag(Rt2, 1); }
    }
    LDS_WAIT(); asm volatile("" ::: "memory");
#undef TAU
#undef OKE
#undef SCRF
#undef BTF
}
template <int STAGE, int WMASK = 31>
__device__ __forceinline__ void rwkv_pre_waves(Frame& F, int l) {
    if (F.wave & 1) { __builtin_amdgcn_s_sleep(127); __builtin_amdgcn_s_sleep(127); }
    for (int it = F.gw; it < RW_ITEMS; it += F.NGW) { { int t_ = F.lane; asm volatile("" : "+v"(t_)); F.lane = t_; } const int c = it % NCH, bh = it / NCH; rwkv_pre_wave<STAGE, WMASK>(F, l, bh >> 3, bh & 7, c); }
}

#ifndef WC_NIF
#define WC_NIF 16
#endif
__device__ __forceinline__ void mix_scan(Frame& F, int l) {
    LAS float* scr = (LAS float*)(F.lds + RING_OFF + F.wave * 16384 + 12288);
    constexpr int NP_R = NB * 8 * 2, NP_GLR = 192, NP_C = NP_R + NP_GLR, NP_S = NB * 32;
    constexpr int NS_R = NS * 8, NS_H = NS * 8, NS_G = NS * 8, NS_S = NS * 32, NSA = NS_R + NS_H + NS_G + NS_S;
    { int t_ = F.lane; asm volatile("" : "+v"(t_)); F.lane = t_; }
    if (F.gw < NP_C) {
        const int r = F.gw;
        if (r < NP_R) { const int sl = r >> 5, u = r & 31; scan_rwkv_chunked(F, l, u >> 3, u & 7, sl); }
        else { const int q = r - NP_R, sl = q / 48, u = q % 48; scan_glr_item(F, l, u < 32 ? ((u >> 3) << 5) | (((u >> 1) & 3) << 3) | ((u & 1) << 2) | sl : 128 + (((u - 32) >> 2) << 4) | (((u - 32) & 3) << 2) | sl); }
        return;
    }
    const int w0 = F.gw - NP_C, ws_ = F.NGW - NP_C;
    if (w0 < NP_S) s5_carry(F, l, w0 >> 5, w0 & 31);
    for (int rp_ = 0; rp_ < DUPN(22); ++rp_)
    for (int it = w0; it < NSA; it += ws_) {
        { int t_ = F.lane; asm volatile("" : "+v"(t_)); F.lane = t_; }
        int r = it; const int sb = NB;
        if (r < NS_R) { scan_rwkv(F, l, sb + (r >> 3), r & 7, scr); continue; } r -= NS_R;
        if (r < NS_H) { scan_glr<128, true>(F, l, sb + (r >> 3), (r >> 1) & 3, r & 1, scr); continue; } r -= NS_H;
        if (r < NS_G) { scan_glr<64, false>(F, l, sb + (r >> 3), (r >> 1) & 3, r & 1, scr); continue; } r -= NS_G;
        scan_s5(F, l, sb + (r >> 5), r & 31);
    }
    for (int rp_ = 0; rp_ < DUPN(23); ++rp_) if (l + 1 < NL) weight_copies<WC_NIF>(F, l + 1, w0, ws_, (LAS float*)(F.lds + RING_OFF + F.wave * 16384));
}
__device__ __forceinline__ void unpack8(const v4u a, float (&o)[8]);
__device__ __forceinline__ void mix_post_a(Frame& F, int l) {
    const bf16* P = WSP(bf16, WS_P); const float* HS = WSP(float, WS_HS); const size_t st = (size_t)M * 2048;
    const float* C_re = GIN(28) + (size_t)l * 32768; const float* C_im = GIN(29) + (size_t)l * 32768; const float* Dv = GIN(30) + (size_t)l * 512;
    bf16* Y5 = WSP(bf16, WS_Y5);
    s5_ygemm(F, l);
    for (int row = MP + (F.NGW - 1 - F.gw); row < M; row += F.NGW) {
        const bf16* p = P + (size_t)row * INP;
#pragma unroll 1
        for (int j = 0; j < 8; ++j) {
            const int col = F.lane + 64 * j, g = col >> 4;
            const f32x4* hr = (const f32x4*)(HS + (size_t)row * 2048 + g * 64); const f32x4* hi = (const f32x4*)(HS + st + (size_t)row * 2048 + g * 64);
            const f32x4* cr = (const f32x4*)(C_re + (size_t)col * 64); const f32x4* ci = (const f32x4*)(C_im + (size_t)col * 64);
            float y = 0.f;
#pragma unroll
            for (int q = 0; q < 16; ++q) { const f32x4 a = hr[q], b = hi[q], c = cr[q], d = ci[q]; y += (a.x * c.x + a.y * c.y + a.z * c.z + a.w * c.w) - (b.x * d.x + b.y * d.y + b.z * d.z + b.w * d.w); }
            y += Dv[col] * bf2f(p[OFF_S + col]);
            Y5[(size_t)row * 512 + col] = (bf16)f2bf(gelu_tanh(y));
        }
    }
}
__device__ __forceinline__ void mix_post_b(Frame& F, int l, int w0, int wstride, int r0, int r1) {
    const bf16* P = WSP(bf16, WS_P); bf16* MIX = WSP(bf16, WS_MIX);
    const bf16* OH = WSP(bf16, WS_OH); const bf16* OG = WSP(bf16, WS_OG); const bf16* OH1 = WSP(bf16, WS_OH1);
    const float* ngh = GIN(34) + (size_t)l * 512; const float* ngg = GIN(37) + (size_t)l * 512;
    const f32x4 la = *(const f32x4*)(GIN(22) + (size_t)l * 512 + 8 * F.lane), lb2 = *(const f32x4*)(GIN(22) + (size_t)l * 512 + 8 * F.lane + 4);
    const f32x4 nh0 = *(const f32x4*)(ngh + 8 * F.lane), nh1 = *(const f32x4*)(ngh + 8 * F.lane + 4), ng0 = *(const f32x4*)(ngg + 8 * F.lane), ng1 = *(const f32x4*)(ngg + 8 * F.lane + 4);
    for (int row = r0 + w0; row < r1; row += wstride) {
        const bf16* p = P + (size_t)row * INP;
        if (row < MP) {
            const int c0 = 8 * F.lane; float y8[8], b8[8]; unpack8(*(const v4u*)(WSP(bf16, WS_RY) + (size_t)row * 512 + c0), y8); unpack8(*(const v4u*)(WSP(bf16, WS_RBV) + (size_t)row * 512 + c0), b8);
            const f32x4 ya = {y8[0], y8[1], y8[2], y8[3]}, yb = {y8[4], y8[5], y8[6], y8[7]}, ba = {b8[0], b8[1], b8[2], b8[3]}, bb = {b8[4], b8[5], b8[6], b8[7]};
            const v4u gw = *(const v4u*)(WSP(bf16, WS_RG) + (size_t)row * 512 + c0);
            float sm = (ya.x + ya.y + ya.z + ya.w) + (yb.x + yb.y + yb.z + yb.w);
            sm += __shfl_xor(sm, 1); sm += __shfl_xor(sm, 2); sm += __shfl_xor(sm, 4);
            const float mean = sm * (1.f / 64.f); const f32x4 da = ya - mean, db = yb - mean;
            float vr = (da.x * da.x + da.y * da.y + da.z * da.z + da.w * da.w) + (db.x * db.x + db.y * db.y + db.z * db.z + db.w * db.w);
            vr += __shfl_xor(vr, 1); vr += __shfl_xor(vr, 2); vr += __shfl_xor(vr, 4);
            const float rs = rsqrtf(vr * (1.f / 64.f) + 64e-5f);
            const f32x4 oa = da * rs * la + ba, ob = db * rs * lb2 + bb;
            v4u w; w.x = pk2(oa.x * bflo(gw.x), oa.y * bfhi(gw.x)); w.y = pk2(oa.z * bflo(gw.y), oa.w * bfhi(gw.y)); w.z = pk2(ob.x * bflo(gw.z), ob.y * bfhi(gw.z)); w.w = pk2(ob.z * bflo(gw.w), ob.w * bfhi(gw.w));
            *(v4u*)(MIX + (size_t)row * D + c0) = w;
        }
        {
            const int c0 = 8 * F.lane;
            float oh[8], og[8];
            unpack8(*(const v4u*)(OH + (size_t)row * 512 + c0), oh);
            if (row < MP) { float o1[8]; unpack8(*(const v4u*)(OH1 + (size_t)row * 512 + c0), o1);
#pragma unroll
                for (int j = 0; j < 8; ++j) oh[j] += o1[j]; }
            unpack8(*(const v4u*)(OG + (size_t)row * 512 + c0), og);
            float gh[8], gg[8]; unpack8(*(const v4u*)(p + OFF_H + 1536 + c0), gh); unpack8(*(const v4u*)(p + OFF_G + 1040 + c0), gg);
            float sh = 0.f, sg = 0.f;
#pragma unroll
            for (int j = 0; j < 8; ++j) { sh += oh[j] * oh[j]; sg += og[j] * og[j]; }
#pragma unroll
            for (int o = 1; o < 16; o <<= 1) { sh += __shfl_xor(sh, o); sg += __shfl_xor(sg, o); }
            const float rh = rsqrtf(sh * (1.f / 128.f) + EPS), rg = rsqrtf(sg * (1.f / 128.f) + EPS);
            const float nh[8] = {nh0.x, nh0.y, nh0.z, nh0.w, nh1.x, nh1.y, nh1.z, nh1.w}, ngv[8] = {ng0.x, ng0.y, ng0.z, ng0.w, ng1.x, ng1.y, ng1.z, ng1.w};
            float yh[8], yg[8];
#pragma unroll
            for (int j = 0; j < 8; ++j) { yh[j] = oh[j] * rh * nh[j] * gh[j] * __builtin_amdgcn_rcpf(1.f + __expf(-gh[j])); yg[j] = og[j] * rg * ngv[j] * gg[j] * __builtin_amdgcn_rcpf(1.f + __expf(-gg[j])); }
            *(v4u*)(MIX + (size_t)row * D + 1024 + c0) = (v4u){pk2(yh[0], yh[1]), pk2(yh[2], yh[3]), pk2(yh[4], yh[5]), pk2(yh[6], yh[7])};
            *(v4u*)(MIX + (size_t)row * D + 1536 + c0) = (v4u){pk2(yg[0], yg[1]), pk2(yg[2], yg[3]), pk2(yg[4], yg[5]), pk2(yg[6], yg[7])};
        }
    }
}
__device__ __forceinline__ float gelu_fast(float x) { const float u = -1.5957691216057308f * (x + 0.044715f * x * x * x); return x * __builtin_amdgcn_rcpf(1.f + __expf(u)); }
__device__ __forceinline__ void unpack8(const v4u a, float (&o)[8]) { o[0] = bflo(a.x); o[1] = bfhi(a.x); o[2] = bflo(a.y); o[3] = bfhi(a.y); o[4] = bflo(a.z); o[5] = bfhi(a.z); o[6] = bflo(a.w); o[7] = bfhi(a.w); }
template <int R>
__device__ __forceinline__ void conv_run(Frame& F, int l, int first, int s, int t0, int n) {
    const bf16* U = WSP(bf16, WS_U); bf16* ACT = WSP(bf16, WS_ACT);
    const float* buf_in = GIN(8) + (size_t)l * NS * 2 * FF; const float* cw = GIN(40) + (size_t)l * 3 * FF; const float* cb = GIN(41) + (size_t)l * FF;
    const bf16* ur = U + (size_t)first * FF2 + n;
    v4u ru[R], rg[R], rh1 = {0u, 0u, 0u, 0u}, rh2 = {0u, 0u, 0u, 0u}; f32x4 fb[2][2];
#pragma unroll
    for (int i = 0; i < R; ++i) { ru[i] = *(const v4u*)(ur + (size_t)i * FF2); rg[i] = *(const v4u*)(ur + (size_t)i * FF2 + FF); }
    if (t0 >= 1) rh1 = *(const v4u*)(ur - FF2);
    if (t0 >= 2) rh2 = *(const v4u*)(ur - 2 * FF2);
    const bool smp = s >= NB;
    if (smp && t0 < 2) {
#pragma unroll
        for (int j = 0; j < 2; ++j) { const f32x4* bp = (const f32x4*)(buf_in + ((size_t)(s - NB) * 2 + j) * FF + n); fb[j][0] = bp[0]; fb[j][1] = bp[1]; } }
    f32x4 w0[2], w1[2], w2[2], bb[2];
#pragma unroll
    for (int hq = 0; hq < 2; ++hq) { w0[hq] = ((const f32x4*)(cw + n))[hq]; w1[hq] = ((const f32x4*)(cw + FF + n))[hq]; w2[hq] = ((const f32x4*)(cw + 2 * FF + n))[hq]; bb[hq] = ((const f32x4*)(cb + n))[hq]; }
    float h1[8], h2[8];
    unpack8(rh1, h1); unpack8(rh2, h2);
    if (smp && t0 < 2) {
#pragma unroll
        for (int j = 0; j < 8; ++j) { const float s1 = fb[1][j >> 2][j & 3], s0 = fb[0][j >> 2][j & 3]; if (t0 == 0) { h1[j] = s1; h2[j] = s0; } else h2[j] = s1; } }
#pragma unroll
    for (int i = 0; i < R; ++i) {
        float u0[8], gg[8], o[8]; unpack8(ru[i], u0); unpack8(rg[i], gg);
#pragma unroll
        for (int j = 0; j < 8; ++j) { const float c = bb[j >> 2][j & 3] + w0[j >> 2][j & 3] * h2[j] + w1[j >> 2][j & 3] * h1[j] + w2[j >> 2][j & 3] * u0[j]; o[j] = gelu_fast(c) * gg[j]; }
        *(v4u*)(ACT + (size_t)(first + i) * FF + n) = (v4u){pk2(o[0], o[1]), pk2(o[2], o[3]), pk2(o[4], o[5]), pk2(o[6], o[7])};
        if (smp && t0 + i >= TS - 2) { float* bo = F.out + O_CVS + (((size_t)l * NS + (s - NB)) * 2 + (t0 + i - (TS - 2))) * FF + n;
            *(f32x4*)bo = (f32x4){u0[0], u0[1], u0[2], u0[3]}; *(f32x4*)(bo + 4) = (f32x4){u0[4], u0[5], u0[6], u0[7]}; }
#pragma unroll
        for (int j = 0; j < 8; ++j) { h2[j] = h1[j]; h1[j] = u0[j]; }
    }
}
__device__ __forceinline__ void conv_rows(Frame& F, int l) {
    constexpr int NA = MP / 64, NBS = NB - 1, NCS = NS, NRUN = NA + NBS + NCS, NCB = (FF + 511) / 512;
    static_assert(MP % 64 == 0 && TS == 4 && (TP % 64) != 63 && (TP % 64) != 0, "prompt rows in 64-row blocks; sample sequences of 4 rows; a 64-row block never starts on the second row of a sequence");
    for (int it = F.gw; it < NRUN * NCB; it += F.NGW) {
        int ln = F.lane; asm volatile("" : "+v"(ln));
        const int idx = it / NCB, cbk = it % NCB, n = cbk * 512 + ln * 8;
        if (n >= FF) continue;
        if (idx < NA) { const int first = 64 * idx; conv_run<2>(F, l, first, first / TP, first % TP, n); }
        else if (idx < NA + NBS) { const int b = idx - NA + 1; conv_run<2>(F, l, b * TP, b, 0, n); }
        else { const int sq = idx - NA - NBS; conv_run<4>(F, l, MP + 4 * sq, NB + sq, 0, n); }
    }
}
#ifndef PROBE_DUP
#define PROBE_DUP 0
#endif
#ifndef RWMASK
#define RWMASK 24
#endif

#ifndef POSTB_SPLIT
#define POSTB_SPLIT 3072
#endif
constexpr int NPH_L = 12, PH_FINAL = 1 + NL * NPH_L, NPHASES = PH_FINAL + 1;
struct Args { const float* in[44]; float* out; unsigned char* ws; int ph_lo, ph_hi; };
__global__ void __launch_bounds__(NTHR, 2) fwd(Args args) {
    extern __shared__ __attribute__((aligned(16))) unsigned char lds[];
    Frame F;
    F.lds = (LAS unsigned char*)lds;
    F.MISC = (volatile LAS unsigned*)(F.lds + MISC_OFF);
    F.tid = threadIdx.x; F.lane = F.tid & 63; F.wave = __builtin_amdgcn_readfirstlane(F.tid >> 6);
    const int wv0 = F.wave;
    F.G = gridDim.x; F.gw = F.wave * F.G + blockIdx.x; F.NGW = F.G * NWAVES;
    F.in = args.in; F.out = args.out; F.ws = args.ws; F.ctl = (unsigned*)(args.ws + WS_CTL);
    for (int u = F.tid; u < (LDS_BYTES - LDSCTL_OFF) / 4; u += NTHR) ((LAS unsigned*)(F.lds + LDSCTL_OFF))[u] = 0u;
    __syncthreads();
    XcdBarrier bar; bar.bar = F.ctl + CW_BAR; bar.x = 0; bar.st = nullptr; bar.wv = wv0;
    if (!MK_PER_PHASE) bar = xcd_barrier_post(F.ctl + CW_BAR, F.MISC + 8, wv0);
    const int lo = args.ph_lo, hi = args.ph_hi;
    bf16 *X, *XN, *P, *MIX, *U, *ACT;
#define IN(k) (!MK_PER_PHASE || (lo <= (k) && (k) < hi))
#define PB() do { int w0_ = wv0; asm volatile("" : "+s"(w0_)); const int t_ = w0_ * 64 + pg8::lane_id(); F.tid = t_; F.lane = t_ & 63; F.wave = w0_; { int g_ = (int)gridDim.x; asm volatile("" : "+s"(g_)); F.G = g_; F.NGW = g_ * NWAVES; } F.gw = F.wave * F.G + (int)blockIdx.x; \
    { GAS unsigned char* w_ = (GAS unsigned char*)args.ws; asm volatile("" : "+s"(w_)); F.ws = (unsigned char*)w_; GAS float* o_ = (GAS float*)args.out; asm volatile("" : "+s"(o_)); F.out = (float*)o_; } \
    X = WSP(bf16, WS_X); XN = WSP(bf16, WS_XN); P = WSP(bf16, WS_P); MIX = WSP(bf16, WS_MIX); U = WSP(bf16, WS_U); ACT = WSP(bf16, WS_ACT); } while (0)
#define SEAM(k) do { if (!MK_PER_PHASE) { XcdBarrier b2_ = bar; asm volatile("" : "+s"(b2_.bar), "+s"(b2_.x), "+s"(b2_.wv)); xcd_barrier(b2_); } } while (0)
    if (IN(0)) { for (int rep_ = 0; rep_ < DUPN(11); ++rep_) { PB(); p0_prologue(F); if (rep_ + 1 < DUPN(11)) { VM_WAIT(); __syncthreads(); } } SEAM(0); }
    for (int l = 0; l < NL; ++l) {
        const int pb = 1 + l * NPH_L;
        if (IN(pb + 1)) { PB();
            if (l > 0 && (int)blockIdx.x < NB_OUTB) { pg8::Gemm g{ACT + (size_t)MA_IN * FF, WSP(bf16, WS_WDN) + (size_t)(l - 1) * D * FF, MPAD - MA_IN, D, FF}; pg8::StaticOrder S; S.init(MPAD - MA_IN, D, NB_OUTB, (int)blockIdx.x);
                pg8::EpiResid<true> E{X + (size_t)MA_IN * D, D, FF / 64, nullptr, WSP(float, WS_SSQ) + (size_t)MA_IN * 32};
                pg8::gemm_phase<pg8::EpiResid<true>, pg8::StaticOrder, true, true>(F.lds + RING_OFF, g, S, E, F.wave); }
            else { pg8::Gemm g{X, WSP(bf16, WS_WIN) + (size_t)l * INP * D, MPAD, INP, D}; pg8::ChainOrder S; S.init(INP, F.G, (int)blockIdx.x, 0, 3, l > 0 ? NB_OUTB : 0, 3, 1); pg8::EpiStoreBf16S E{P, INP, WSP(float, WS_SSQ)};
                pg8::gemm_phase<pg8::EpiStoreBf16S, pg8::ChainOrder, true, true>(F.lds + RING_OFF, g, S, E, F.wave); }
            SEAM(pb + 1); }
        const int nin2 = NB_IN + (l > 0 ? 3 * NB_OUTB : 0), niw = (F.G - nin2) * 8 < 1472 ? (F.G - nin2) * 8 : 1472;
        if (IN(pb + 2)) { PB();
            if ((int)blockIdx.x < nin2) { pg8::Gemm g{X, WSP(bf16, WS_WIN) + (size_t)l * INP * D, MPAD, INP, D}; pg8::ChainOrder S; S.init(INP, F.G, (int)blockIdx.x, 1, 3, l > 0 ? NB_OUTB : 0, 3, 1); pg8::EpiStoreBf16S E{P, INP, WSP(float, WS_SSQ)};
                pg8::gemm_phase<pg8::EpiStoreBf16S, pg8::ChainOrder, true, true>(F.lds + RING_OFF, g, S, E, F.wave); }
            else glr_pre(F, l, 0, (int)blockIdx.x - nin2, F.G - nin2, niw);
            SEAM(pb + 2); }
        if (IN(pb + 3)) { for (int rep_ = 0; rep_ < DUPN(2); ++rep_) { PB(); { const int nbusy = RW_ITEMS > F.NGW ? (RW_ITEMS - F.NGW < F.G / 2 ? RW_ITEMS - F.NGW : 0) : 0; if ((int)blockIdx.x >= nbusy) glr_pre(F, l, 1, F.G - 1 - (int)blockIdx.x, F.G - nbusy, niw); }        for (int r2_ = 0; r2_ < DUPN(13); ++r2_) { rwkv_pre_waves<2, 31>(F, l); __syncthreads(); } for (int r2_ = 0; r2_ < DUPN(14); ++r2_) { mix_pre(F, l); __syncthreads(); } s5_egemm(F, l); if (rep_ + 1 < DUPN(2)) { VM_WAIT(); __syncthreads(); } } SEAM(pb + 3); }
        if (IN(pb + 4)) { for (int rep_ = 0; rep_ < DUPN(3); ++rep_) { PB(); mix_scan(F, l); if (rep_ + 1 < DUPN(3)) { VM_WAIT(); __syncthreads(); } } SEAM(pb + 4); }
        if (IN(pb + 5)) { for (int rep_ = 0; rep_ < DUPN(4); ++rep_) { PB(); mix_post_a(F, l); mix_post_b(F, l, F.gw, F.NGW, 0, POSTB_SPLIT);        if (rep_ + 1 < DUPN(4)) { VM_WAIT(); __syncthreads(); } } SEAM(pb + 5); }
        if (IN(pb + 6)) { for (int rep_ = 0; rep_ < DUPN(5); ++rep_) { PB(); pg8::Gemm g{WSP(bf16, WS_Y5), WSP(bf16, WS_WGLUT) + (size_t)l * 512 * 512, MPAD, 512, 512}; pg8::StaticOrder S; S.init(MPAD, 512, F.G, (int)blockIdx.x);
            pg8::EpiGlu E{MIX + 512, D, WSP(bf16, WS_Y5), 512, GIN(32) + (size_t)l * 512};
            pg8::gemm_phase<pg8::EpiGlu, pg8::StaticOrder, true, true>(F.lds + RING_OFF, g, S, E, F.wave);
            { constexpr int NGLU = (MPAD / 256) * 2; if ((int)blockIdx.x >= NGLU) mix_post_b(F, l, F.wave * (F.G - NGLU) + ((int)blockIdx.x - NGLU), (F.G - NGLU) * NWAVES, POSTB_SPLIT, M); } if (rep_ + 1 < DUPN(5)) { VM_WAIT(); __syncthreads(); } } SEAM(pb + 6); }
        if (IN(pb + 7)) { PB(); pg8::Gemm g{MIX, WSP(bf16, WS_WOUT) + (size_t)l * D * D, MA_IN, D, D}; pg8::StaticOrder S; S.init(MA_IN, D, F.G, (int)blockIdx.x); pg8::EpiResid<true> E{X, D, D / 64, nullptr, WSP(float, WS_SSQ)};
            pg8::gemm_phase<pg8::EpiResid<true>, pg8::StaticOrder, true, true>(F.lds + RING_OFF, g, S, E, F.wave); SEAM(pb + 7); }
        if (IN(pb + 8)) { PB();
            if ((int)blockIdx.x < NB_OUTB) { pg8::Gemm g{MIX + (size_t)MA_IN * D, WSP(bf16, WS_WOUT) + (size_t)l * D * D, MPAD - MA_IN, D, D}; pg8::StaticOrder S; S.init(MPAD - MA_IN, D, NB_OUTB, (int)blockIdx.x);
                pg8::EpiResid<true> E{X + (size_t)MA_IN * D, D, D / 64, nullptr, WSP(float, WS_SSQ) + (size_t)MA_IN * 32};
                pg8::gemm_phase<pg8::EpiResid<true>, pg8::StaticOrder, true, true>(F.lds + RING_OFF, g, S, E, F.wave); VM_WAIT(); __syncthreads(); PB(); }
            { pg8::Gemm g{X, WSP(bf16, WS_WUP) + (size_t)l * FF2 * D, MPAD, FF2, D}; pg8::ChainOrder S; S.init(FF2, F.G, (int)blockIdx.x, 0, UP1_ROUNDS, NB_OUTB, 1, 0); pg8::EpiConvAct E{ACT, U, GIN(40) + (size_t)l * 3 * FF, GIN(41) + (size_t)l * FF, F.out + O_CVP + (size_t)l * NB * 2 * FF, WSP(float, WS_SSQ)};
              pg8::gemm_phase<pg8::EpiConvAct, pg8::ChainOrder, true, true>(F.lds + RING_OFF, g, S, E, F.wave); }
            SEAM(pb + 8); }
        if (IN(pb + 9)) { PB(); pg8::Gemm g{X, WSP(bf16, WS_WUP) + (size_t)l * FF2 * D, MPAD, FF2, D}; pg8::ChainOrder S; S.init(FF2, F.G, (int)blockIdx.x, 1, UP1_ROUNDS, NB_OUTB, 1, 0); pg8::EpiConvAct E{ACT, U, GIN(40) + (size_t)l * 3 * FF, GIN(41) + (size_t)l * FF, F.out + O_CVP + (size_t)l * NB * 2 * FF, WSP(float, WS_SSQ)};
            pg8::gemm_phase<pg8::EpiConvAct, pg8::ChainOrder, true, true>(F.lds + RING_OFF, g, S, E, F.wave); SEAM(pb + 9); }
        if (IN(pb + 10)) { for (int rep_ = 0; rep_ < DUPN(9); ++rep_) { PB(); conv_rows(F, l); if (rep_ + 1 < DUPN(9)) { VM_WAIT(); __syncthreads(); } } SEAM(pb + 10); }
        if (IN(pb + 11)) { PB();
            if (l + 1 < NL) { pg8::Gemm g{ACT, WSP(bf16, WS_WDN) + (size_t)l * D * FF, MA_IN, D, FF}; pg8::StaticOrder S; S.init(MA_IN, D, F.G, (int)blockIdx.x); pg8::EpiResid<true> E{X, D, FF / 64, nullptr, WSP(float, WS_SSQ)};
                pg8::gemm_phase<pg8::EpiResid<true>, pg8::StaticOrder, true, true>(F.lds + RING_OFF, g, S, E, F.wave); }
            else { pg8::Gemm g{ACT, WSP(bf16, WS_WDN) + (size_t)l * D * FF, MPAD, D, FF}; pg8::SplitTailOrder S; S.init2(MPAD, D, FF, F.G, (int)blockIdx.x); pg8::EpiResid<false> E{X, D, FF / 64, WSP(float, WS_SLAB), nullptr};
                pg8::gemm_phase<pg8::EpiResid<false>, pg8::SplitTailOrder, true, true>(F.lds + RING_OFF, g, S, E, F.wave); }
            SEAM(pb + 11); }
    }
    if (IN(PH_FINAL)) { PB(); final_rows(F, X, GIN(43), F.out); }
#undef IN
#undef SEAM
}

extern "C" void kernel_launch(void* const* d_in, const int* in_sizes, int n_in, void* d_out, int out_size, void* d_ws, size_t ws_size, hipStream_t stream) {
    static int grid = 0;
    if (grid == 0) {
        if (n_in != 44 || (size_t)out_size != O_END || ws_size < WS_END) { fprintf(stderr, "kernel_launch: built for 44 inputs, %zu outputs, >= %zu bytes of workspace; got %d, %d, %zu; nothing launched\n", (size_t)O_END, (size_t)WS_END, n_in, out_size, ws_size); grid = -1; return; }
        int dev = 0, cus = 0, per_cu = 0;
        if (hipGetDevice(&dev) != hipSuccess || hipDeviceGetAttribute(&cus, hipDeviceAttributeMultiprocessorCount, dev) != hipSuccess) { fprintf(stderr, "kernel_launch: device query failed\n"); grid = -1; return; }
        if (hipFuncSetAttribute((const void*)fwd, hipFuncAttributeMaxDynamicSharedMemorySize, LDS_BYTES) != hipSuccess) { fprintf(stderr, "kernel_launch: hipFuncSetAttribute failed\n"); grid = -1; return; }
        if (hipOccupancyMaxActiveBlocksPerMultiprocessor(&per_cu, (const void*)fwd, NTHR, LDS_BYTES) != hipSuccess || per_cu < 1) fprintf(stderr, "kernel_launch: note: occupancy query reports %d workgroups per CU\n", per_cu);
        (void)hipGetLastError();
        grid = cus;
    }
    if (grid < 0) return;
    if (hipMemsetAsync((char*)d_ws + WS_CTL, 0, CTL_ZERO_BYTES, stream) != hipSuccess) { fprintf(stderr, "kernel_launch: memset failed\n"); return; }
    Args a{};
    for (int i = 0; i < 44; ++i) a.in[i] = (const float*)d_in[i];
    a.out = (float*)d_out; a.ws = (unsigned char*)d_ws;
#if MK_PER_PHASE
    for (int ph = 0; ph < NPHASES; ++ph) { a.ph_lo = ph; a.ph_hi = ph + 1; hipLaunchKernelGGL(fwd, dim3(grid), dim3(NTHR), LDS_BYTES, stream, a); }
#else
    a.ph_lo = 0; a.ph_hi = NPHASES; hipLaunchKernelGGL(fwd, dim3(grid), dim3(NTHR), LDS_BYTES, stream, a);
#endif
    const hipError_t le = hipPeekAtLastError();
    if (le != hipSuccess) fprintf(stderr, "kernel_launch: launch failed: %s\n", hipGetErrorName(le));
}
```

```cpp
#include <hip/hip_runtime.h>
#include <cstdio>
#include <cstdint>
#define MK_PER_PHASE 0
#define PROBE_DUP 0
namespace pg8 {
__device__ __forceinline__ int lane_id() { unsigned m_ = ~0u; asm volatile("" : "+s"(m_)); return (int)__builtin_amdgcn_mbcnt_hi(m_, __builtin_amdgcn_mbcnt_lo(m_, 0u)); }
#define PG8_LAS __attribute__((address_space(3)))
typedef unsigned short bf16_t;
typedef short bf16x8 __attribute__((ext_vector_type(8)));
typedef float f32x4 __attribute__((ext_vector_type(4)));
typedef unsigned u32x4 __attribute__((ext_vector_type(4)));
constexpr int BM = 256, BK = 64, HALF = 128, HTB = HALF * BK * 2  , STAGE_BYTES = 8 * HTB, NXCD = 8, WGM = 8;

__host__ __device__ __forceinline__ int lds_byte(int r, int c) { const int st = (r >> 4) * 2 + (c >> 5), rr = r & 15, cc = c & 31, ob = rr * 64 + cc * 2; return st * 1024 + (ob ^ (((ob >> 9) & 1) << 5)); }
__host__ __device__ __forceinline__ void stage_rc(int b, int& R, int& C) { const int st = b / 1024, sb = b % 1024, swz = sb ^ (((sb >> 9) & 1) << 5); R = (st >> 1) * 16 + swz / 64; C = (st & 1) * 32 + (swz % 64) / 2; }
__host__ __device__ __forceinline__ int perm32(int rho) { const int n = rho >> 4, i = rho & 15; return 8 * (i >> 2) + 4 * n + (i & 3); }

struct Unit { int pm, pn, k0, nt, part; };
struct Gemm { const bf16_t* A; const bf16_t* Bt; int M, N, K; };

struct StaticOrder {
    int nM, nN, nwg, G, c;
    __host__ __device__ __forceinline__ void init(int M, int N, int G_, int c_) { nM = M / BM; nN = N / BM; nwg = nM * nN; G = G_; c = c_; }
    __host__ __device__ __forceinline__ bool next(int i, Unit& u) const {
        const long L = (long)i * G + c; if (L >= nwg) return false;
        int wgid = (int)L; { const int q = nwg / NXCD, r = nwg % NXCD, xcd = wgid % NXCD, off = wgid / NXCD; wgid = (xcd < r ? xcd * (q + 1) : r * (q + 1) + (xcd - r) * q) + off; }
        const int nig = WGM * nN, gid = wgid / nig, fm = gid * WGM, gsz = (nM - fm) < WGM ? (nM - fm) : WGM;
        u.pm = fm + ((wgid % nig) % gsz); u.pn = (wgid % nig) / gsz; u.k0 = 0; u.nt = 0; u.part = 0; return true;
    }
    __device__ __forceinline__ void a_ready(const Unit&) const {}
    __device__ __forceinline__ void done(const Unit&) const {}
};

struct SplitTailOrder : StaticOrder {
    int full, rem, P, np;
    __host__ __device__ __forceinline__ void init2(int M, int N, int K, int G_, int c_) { init(M, N, G_, c_); full = nwg / G; rem = nwg - full * G; np = K / (2 * BK); P = rem ? G / rem : 1; if (P > np / 2) P = np / 2; if (P < 1) P = 1; }
    __host__ __device__ __forceinline__ bool next(int i, Unit& u) const {
        if (i < full) return StaticOrder::next(i, u);
        if (i > full || rem == 0 || c >= rem * P) return false;
        const int ru = c % rem, p = c / rem;
        StaticOrder t = *this; t.c = ru; if (!t.StaticOrder::next(full, u)) return false;
        const int p0 = (p * np) / P, p1 = ((p + 1) * np) / P; u.k0 = 2 * p0; u.nt = 2 * (p1 - p0); u.part = ru * P + p; return true;
    }
};
typedef float f32x2c_ __attribute__((ext_vector_type(2)));
typedef __bf16 bf16x2c_ __attribute__((ext_vector_type(2)));
__device__ __forceinline__ unsigned cvt_pk_bf16(float lo, float hi) { const f32x2c_ v = {lo, hi}; const bf16x2c_ b = __builtin_convertvector(v, bf16x2c_); return __builtin_bit_cast(unsigned, b); }
typedef float f32x2 __attribute__((ext_vector_type(2)));
template <class Epi, class Sched, bool ALIGN_EPI = false, bool SP2 = false>
__device__ __forceinline__ void gemm_phase(PG8_LAS unsigned char* lds, const Gemm g, const Sched& S, const Epi& E, int wave_in) {
    int wv_ = wave_in; asm volatile("" : "+s"(wv_)); const int tid = wv_ * 64 + lane_id(), wid = __builtin_amdgcn_readfirstlane(tid >> 6), lane = tid & 63, wr = wid >> 2, wc = wid & 3, fr = lane & 15, fq = lane >> 4;
    const int K = g.K, ntK = K / BK;
    unsigned voffA[2], voffB[2];
#pragma unroll
    for (int i = 0; i < 2; ++i) { int R, C; stage_rc(tid * 16 + i * 8192, R, C); const int Rb = Epi::PERM ? ((R & ~31) + perm32(R & 31)) : R;
        voffA[i] = (unsigned)(R * K + C) * 2u; voffB[i] = (unsigned)(Rb * K + C) * 2u; }
    const size_t kstep = (size_t)(BK * 2);
    const size_t hstep = (size_t)HALF * K * 2;
    const size_t tstep = 2 * hstep;
    const unsigned ldsw = (unsigned)wid * 1024u;
    const int aoff = lds_byte(wr * 64 + fr, fq * 8), boff = lds_byte(wc * 32 + fr, fq * 8);
#define PG8_SA(b, h) (((b) * 2 + (h)) * HTB)
#define PG8_SB(b, h) ((4 + (b) * 2 + (h)) * HTB)
#define PG8_STAGE(bufoff, gbase, voff) do { _Pragma("unroll") for (int _i = 0; _i < 2; ++_i) \
        __builtin_amdgcn_global_load_lds((const unsigned*)((const char*)(gbase) + (voff)[_i]), (PG8_LAS unsigned*)(lds + (bufoff) + ldsw + _i * 8192), 16, 0, 0); } while (0)
#define PG8_LDA(dst, b, h) do { _Pragma("unroll") for (int m = 0; m < 4; ++m) _Pragma("unroll") for (int k = 0; k < 2; ++k) dst[m][k] = *(const PG8_LAS bf16x8*)(lds + PG8_SA(b, h) + aoff + m * 2048 + k * 1024); } while (0)
#define PG8_LDB(dst, b, h) do { _Pragma("unroll") for (int n = 0; n < 2; ++n) _Pragma("unroll") for (int k = 0; k < 2; ++k) dst[n][k] = *(const PG8_LAS bf16x8*)(lds + PG8_SB(b, h) + boff + n * 2048 + k * 1024); } while (0)
#define PG8_MMA(ai, bj, At, Bt) do { __builtin_amdgcn_s_setprio(1); _Pragma("unroll") for (int m = 0; m < 4; ++m) _Pragma("unroll") for (int n = 0; n < 2; ++n) _Pragma("unroll") for (int k = 0; k < 2; ++k) \
        acc[ai][bj][m][n] = __builtin_amdgcn_mfma_f32_16x16x32_bf16(Bt[n][k], At[m][k], acc[ai][bj][m][n], 0, 0, 0); __builtin_amdgcn_s_setprio(0); } while (0)
#define PG8_WAIT_V(n) asm volatile("s_waitcnt vmcnt(" #n ")" ::: "memory")
#define PG8_WAIT_L(n) asm volatile("s_waitcnt lgkmcnt(" #n ")" ::: "memory")
#define PG8_BAR __builtin_amdgcn_s_barrier()
#define PG8_SCHED __builtin_amdgcn_sched_barrier(0)
    Unit cur, nxt; int ui = 0;
    if (!S.next(0, cur)) return;
    if (cur.nt == 0) cur.nt = ntK;
    f32x4 acc[2][2][4][2];
#pragma unroll
    for (int a = 0; a < 2; ++a)
#pragma unroll
        for (int b = 0; b < 2; ++b)
#pragma unroll
            for (int m = 0; m < 4; ++m)
#pragma unroll
                for (int n = 0; n < 2; ++n) acc[a][b][m][n] = (f32x4){0.f, 0.f, 0.f, 0.f};
    bf16x8 At[4][2], B0[2][2], B1[2][2];
    const char* cA = (const char*)g.A + (size_t)cur.pm * tstep + (size_t)cur.k0 * kstep; const char* cB = (const char*)g.Bt + (size_t)cur.pn * tstep + (size_t)cur.k0 * kstep;
    S.a_ready(cur);
    if constexpr (SP2) {
        PG8_STAGE(PG8_SB(0, 0), cB, voffB); PG8_STAGE(PG8_SB(0, 1), cB + hstep, voffB); PG8_STAGE(PG8_SA(0, 0), cA, voffA); PG8_STAGE(PG8_SA(0, 1), cA + hstep, voffA);
        if (wr == 1) PG8_BAR;
        PG8_WAIT_V(2); PG8_BAR;
        PG8_STAGE(PG8_SB(1, 0), cB + kstep, voffB); PG8_STAGE(PG8_SA(1, 0), cA + kstep, voffA); PG8_STAGE(PG8_SB(1, 1), cB + hstep + kstep, voffB);
        PG8_WAIT_V(6); PG8_BAR;
    } else {
        PG8_STAGE(PG8_SB(0, 0), cB, voffB); PG8_STAGE(PG8_SA(0, 0), cA, voffA); PG8_STAGE(PG8_SB(0, 1), cB + hstep, voffB); PG8_STAGE(PG8_SA(0, 1), cA + hstep, voffA);
        if (wr == 1) PG8_BAR;
        PG8_WAIT_V(4); PG8_BAR;
        PG8_STAGE(PG8_SB(1, 0), cB + kstep, voffB); PG8_STAGE(PG8_SA(1, 0), cA + kstep, voffA); PG8_STAGE(PG8_SB(1, 1), cB + hstep + kstep, voffB);
        PG8_WAIT_V(6); PG8_BAR;
    }
    for (;;) {
        const bool has_next = S.next(ui + 1, nxt);
        if (has_next && nxt.nt == 0) nxt.nt = ntK;
        const int nt = cur.nt;
        const char* nA = has_next ? (const char*)g.A + (size_t)nxt.pm * tstep + (size_t)nxt.k0 * kstep : cA; const char* nB = has_next ? (const char*)g.Bt + (size_t)nxt.pn * tstep + (size_t)nxt.k0 * kstep : cB;
        for (int t = 0; t < nt; t += 2) {
            const bool last = (t == nt - 2);
            const char* a1 = cA + (size_t)(t + 1) * kstep;
            const char* a2 = last ? nA : cA + (size_t)(t + 2) * kstep; const char* b2 = last ? nB : cB + (size_t)(t + 2) * kstep;
            const char* a3 = a2 + kstep; const char* b3 = b2 + kstep;
            if (last && has_next) S.a_ready(nxt);
            if constexpr (SP2) {
            PG8_LDB(B0, 0, 0); PG8_LDB(B1, 0, 1); PG8_SCHED; PG8_LDA(At, 0, 0); PG8_STAGE(PG8_SA(1, 1), a1 + hstep, voffA);
            PG8_WAIT_V(8); PG8_WAIT_L(0); PG8_BAR; PG8_MMA(0, 0, At, B0); PG8_MMA(0, 1, At, B1); PG8_BAR; PG8_SCHED;
            PG8_LDA(At, 0, 1); PG8_STAGE(PG8_SB(0, 0), b2, voffB); PG8_STAGE(PG8_SB(0, 1), b2 + hstep, voffB); PG8_STAGE(PG8_SA(0, 0), a2, voffA);
            PG8_WAIT_V(8); PG8_WAIT_L(0); PG8_BAR; PG8_MMA(1, 0, At, B0); PG8_MMA(1, 1, At, B1); PG8_BAR; PG8_SCHED;
            PG8_LDB(B0, 1, 0); PG8_LDB(B1, 1, 1); PG8_SCHED; PG8_LDA(At, 1, 0); PG8_STAGE(PG8_SA(0, 1), a2 + hstep, voffA);
            PG8_WAIT_V(8); PG8_WAIT_L(0); PG8_BAR; PG8_MMA(0, 0, At, B0); PG8_MMA(0, 1, At, B1); PG8_BAR; PG8_SCHED;
            PG8_LDA(At, 1, 1); PG8_STAGE(PG8_SB(1, 0), b3, voffB); PG8_STAGE(PG8_SB(1, 1), b3 + hstep, voffB); PG8_STAGE(PG8_SA(1, 0), a3, voffA);
            PG8_WAIT_V(8); PG8_WAIT_L(0); PG8_BAR; PG8_MMA(1, 0, At, B0); PG8_MMA(1, 1, At, B1); PG8_BAR; PG8_SCHED;
            } else {
            PG8_LDB(B0, 0, 0); PG8_SCHED; PG8_LDA(At, 0, 0); PG8_STAGE(PG8_SA(1, 1), a1 + hstep, voffA);
            PG8_WAIT_L(8); PG8_BAR; PG8_WAIT_L(0); PG8_MMA(0, 0, At, B0); PG8_BAR; PG8_SCHED;
            PG8_LDB(B1, 0, 1); PG8_STAGE(PG8_SB(0, 0), b2, voffB);
            PG8_BAR; PG8_WAIT_L(0); PG8_MMA(0, 1, At, B1); PG8_BAR;
            PG8_LDA(At, 0, 1); PG8_STAGE(PG8_SA(0, 0), a2, voffA);
            PG8_BAR; PG8_WAIT_L(0); PG8_MMA(1, 0, At, B0); PG8_BAR; PG8_SCHED;
            PG8_STAGE(PG8_SB(0, 1), b2 + hstep, voffB);
            PG8_WAIT_V(6); PG8_BAR; PG8_MMA(1, 1, At, B1); PG8_BAR;
            PG8_LDB(B0, 1, 0); PG8_SCHED; PG8_LDA(At, 1, 0); PG8_STAGE(PG8_SA(0, 1), a2 + hstep, voffA);
            PG8_WAIT_L(8); PG8_BAR; PG8_WAIT_L(0); PG8_MMA(0, 0, At, B0); PG8_BAR; PG8_SCHED;
            PG8_LDB(B1, 1, 1); PG8_STAGE(PG8_SB(1, 0), b3, voffB);
            PG8_BAR; PG8_WAIT_L(0); PG8_MMA(0, 1, At, B1); PG8_BAR;
            PG8_LDA(At, 1, 1); PG8_STAGE(PG8_SA(1, 0), a3, voffA);
            PG8_BAR; PG8_WAIT_L(0); PG8_MMA(1, 0, At, B0); PG8_BAR; PG8_SCHED;
            PG8_STAGE(PG8_SB(1, 1), b3 + hstep, voffB);
            PG8_WAIT_V(6); PG8_BAR; PG8_MMA(1, 1, At, B1); PG8_BAR;
            }
        }
        if constexpr (ALIGN_EPI) { if (wr == 0) PG8_BAR; }
        if constexpr (!Epi::AFTER_DRAIN) { E(acc, cur, wr, wc, fr, fq); S.done(cur); }
        if (!has_next) break;
#pragma unroll
        for (int a = 0; a < 2; ++a)
#pragma unroll
            for (int b = 0; b < 2; ++b)
#pragma unroll
                for (int m = 0; m < 4; ++m)
#pragma unroll
                    for (int n = 0; n < 2; ++n) acc[a][b][m][n] = (f32x4){0.f, 0.f, 0.f, 0.f};
        cur = nxt; cA = nA; cB = nB; ++ui;
        if constexpr (ALIGN_EPI) { if (wr == 1) PG8_BAR; }
    }
    PG8_WAIT_V(0);
    if constexpr (!ALIGN_EPI) { if (wr == 0) PG8_BAR; }
    PG8_BAR;
    if constexpr (Epi::AFTER_DRAIN) { E.fused(acc, cur, wr, wc, fr, fq, lds, wid, lane); S.done(cur); }
#undef PG8_SA
#undef PG8_SB
#undef PG8_STAGE
#undef PG8_LDA
#undef PG8_LDB
#undef PG8_MMA
#undef PG8_WAIT_V
#undef PG8_WAIT_L
#undef PG8_BAR
#undef PG8_SCHED
}
}
namespace pg8 {
struct EpiStoreBf16 {
    static constexpr bool PERM = true, AFTER_DRAIN = false;
    bf16_t* O; int ldc;
    __device__ __forceinline__ void operator()(const f32x4 (&acc)[2][2][4][2], const Unit& u, int wr, int wc, int fr, int fq) const {
        const int row0 = u.pm * BM + wr * 64 + fr, col0 = u.pn * BM + wc * 32 + 8 * fq;
#pragma unroll
        for (int ai = 0; ai < 2; ++ai)
#pragma unroll
            for (int m = 0; m < 4; ++m) { bf16_t* rowp = O + (size_t)(row0 + ai * HALF + m * 16) * ldc + col0;
#pragma unroll
                for (int bj = 0; bj < 2; ++bj) { const f32x4 v0 = acc[ai][bj][m][0], v1 = acc[ai][bj][m][1];
                    u32x4 w; w.x = cvt_pk_bf16(v0[0], v0[1]); w.y = cvt_pk_bf16(v0[2], v0[3]); w.z = cvt_pk_bf16(v1[0], v1[1]); w.w = cvt_pk_bf16(v1[2], v1[3]);
                    *(u32x4*)(rowp + bj * HALF) = w; } }
    }
};
template <bool SSQ_>
struct EpiResid {
    static constexpr bool PERM = true, AFTER_DRAIN = false;
    bf16_t* X; int ldc; int ntK; float* slab; float* ssq;
    __device__ __forceinline__ void operator()(const f32x4 (&acc)[2][2][4][2], const Unit& u, int wr, int wc, int fr, int fq) const {
        const int row0 = u.pm * BM + wr * 64 + fr, col0 = u.pn * BM + wc * 32 + 8 * fq;
        if (!SSQ_ && u.nt != ntK) {
            bf16_t* sl = (bf16_t*)slab + (size_t)u.part * (BM * BM) + (size_t)(wr * 64 + fr) * BM + wc * 32 + 8 * fq;
#pragma unroll
            for (int ai = 0; ai < 2; ++ai)
#pragma unroll
                for (int m = 0; m < 4; ++m)
#pragma unroll
                    for (int bj = 0; bj < 2; ++bj) { const f32x4 v0 = acc[ai][bj][m][0], v1 = acc[ai][bj][m][1];
                        u32x4 w; w.x = cvt_pk_bf16(v0[0], v0[1]); w.y = cvt_pk_bf16(v0[2], v0[3]); w.z = cvt_pk_bf16(v1[0], v1[1]); w.w = cvt_pk_bf16(v1[2], v1[3]);
                        *(u32x4*)(sl + (size_t)(ai * HALF + m * 16) * BM + bj * HALF) = w; }
            return;
        }
#pragma unroll
        for (int ai = 0; ai < 2; ++ai) {
            u32x4 old[4][2];
#pragma unroll
            for (int m = 0; m < 4; ++m)
#pragma unroll
                for (int bj = 0; bj < 2; ++bj) old[m][bj] = *(const u32x4*)(X + (size_t)(row0 + ai * HALF + m * 16) * ldc + col0 + bj * HALF);
#pragma unroll
            for (int m = 0; m < 4; ++m) { const int row = row0 + ai * HALF + m * 16; bf16_t* rowp = X + (size_t)row * ldc + col0;
                float sq = 0.f;
#pragma unroll
                for (int bj = 0; bj < 2; ++bj) { const f32x4 v0 = acc[ai][bj][m][0], v1 = acc[ai][bj][m][1]; const u32x4 o = old[m][bj];
                    float t[8];
                    t[0] = __builtin_bit_cast(float, o.x << 16) + v0[0]; t[1] = __builtin_bit_cast(float, o.x & 0xffff0000u) + v0[1];
                    t[2] = __builtin_bit_cast(float, o.y << 16) + v0[2]; t[3] = __builtin_bit_cast(float, o.y & 0xffff0000u) + v0[3];
                    t[4] = __builtin_bit_cast(float, o.z << 16) + v1[0]; t[5] = __builtin_bit_cast(float, o.z & 0xffff0000u) + v1[1];
                    t[6] = __builtin_bit_cast(float, o.w << 16) + v1[2]; t[7] = __builtin_bit_cast(float, o.w & 0xffff0000u) + v1[3];
                    u32x4 w; w.x = cvt_pk_bf16(t[0], t[1]); w.y = cvt_pk_bf16(t[2], t[3]); w.z = cvt_pk_bf16(t[4], t[5]); w.w = cvt_pk_bf16(t[6], t[7]);
                    *(u32x4*)(rowp + bj * HALF) = w;
                    if (SSQ_) {
#pragma unroll
                        for (int j = 0; j < 8; ++j) sq += t[j] * t[j]; } }
                if (SSQ_) { sq += __shfl_xor(sq, 16); sq += __shfl_xor(sq, 32); if (fq == 0) ssq[(size_t)row * 32 + u.pn * 4 + wc] = sq; } }
        }
    }
};
}
namespace pg8 {
struct EpiGlu {
    static constexpr bool PERM = true, AFTER_DRAIN = false;
    bf16_t* O; int ldc; const bf16_t* Y; int ldy; const float* bias;
    __device__ __forceinline__ void operator()(const f32x4 (&acc)[2][2][4][2], const Unit& u, int wr, int wc, int fr, int fq) const {
        const int row0 = u.pm * BM + wr * 64 + fr, col0 = u.pn * BM + wc * 32 + 8 * fq;
#pragma unroll
        for (int bj = 0; bj < 2; ++bj) { const f32x4 b0 = *(const f32x4*)(bias + col0 + bj * HALF), b1 = *(const f32x4*)(bias + col0 + bj * HALF + 4);
            u32x4 yv[2][4];
#pragma unroll
            for (int ai = 0; ai < 2; ++ai)
#pragma unroll
                for (int m = 0; m < 4; ++m) yv[ai][m] = *(const u32x4*)(Y + (size_t)(row0 + ai * HALF + m * 16) * ldy + col0 + bj * HALF);
#pragma unroll
            for (int ai = 0; ai < 2; ++ai)
#pragma unroll
                for (int m = 0; m < 4; ++m) { const size_t row = (size_t)(row0 + ai * HALF + m * 16);
                    const u32x4 yw = yv[ai][m];
                    const f32x4 v0 = acc[ai][bj][m][0] + b0, v1 = acc[ai][bj][m][1] + b1;
                    float y[8];
#pragma unroll
                    for (int j = 0; j < 4; ++j) { y[2 * j] = __builtin_bit_cast(float, yw[j] << 16); y[2 * j + 1] = __builtin_bit_cast(float, yw[j] & 0xffff0000u); }
                    float o[8];
#pragma unroll
                    for (int j = 0; j < 4; ++j) { o[j] = y[j] * __builtin_amdgcn_rcpf(1.f + __expf(-v0[j])); o[4 + j] = y[4 + j] * __builtin_amdgcn_rcpf(1.f + __expf(-v1[j])); }
                    u32x4 w; w.x = cvt_pk_bf16(o[0], o[1]); w.y = cvt_pk_bf16(o[2], o[3]); w.z = cvt_pk_bf16(o[4], o[5]); w.w = cvt_pk_bf16(o[6], o[7]);
                    *(u32x4*)(O + row * ldc + col0 + bj * HALF) = w; } }
    }
};
}
#ifndef PROBE_DUP
#define PROBE_DUP 0
#endif
#define DUPN(k) (((PROBE_DUP) >> (k)) & 1 ? 2 : 1)
#ifndef MK_PER_PHASE
#define MK_PER_PHASE 0
#endif
constexpr int D = 2048, NB = 4, SEQ = 2048, NL = 4, NS = 128, TS = 4, NMETA = 16;
constexpr int TP = SEQ + NMETA, MP = NB * TP, MS = NS * TS, M = MP + MS, MPAD = 8960, NSEQ = NB + NS;
constexpr int RC = 1792, SC = 512, HC = 2048, GC = 1552, INC = RC + SC + HC + GC, INP = 6144;
constexpr int OFF_R = 0, OFF_S = RC, OFF_H = RC + SC, OFF_G = RC + SC + HC;
constexpr int FF = 5504, FF2 = 2 * FF;
constexpr float EPS = 1e-6f;
static_assert(INC == 5904 && MPAD % 256 == 0 && MPAD >= M && INP % 256 == 0 && FF2 % 256 == 0 && FF % 128 == 0, "shapes");
constexpr int NWAVES = 8, NTHR = 512;
constexpr int MA_IN = 8192, NB_IN = ((MPAD - MA_IN) / 256) * (INP / 256), NB_OUTB = ((MPAD - MA_IN) / 256) * (D / 256), UP1_ROUNDS = 5;
constexpr int RW_ITEMS = NB * 8 * 65, RW_XWG = 4;
constexpr size_t O_YP = 0;
constexpr size_t O_YS = O_YP + (size_t)NB * SEQ * D;
constexpr size_t O_RWP = O_YS + (size_t)NS * TS * D;
constexpr size_t O_RWS = O_RWP + (size_t)NL * NB * 8 * 64 * 64;
constexpr size_t O_SHP = O_RWS + (size_t)NL * NS * 8 * 64 * 64;
constexpr size_t O_SHS = O_SHP + (size_t)NL * NB * RC;
constexpr size_t O_SRP = O_SHS + (size_t)NL * NS * RC;
constexpr size_t O_SRS = O_SRP + (size_t)NL * NB * 2048;
constexpr size_t O_SIP = O_SRS + (size_t)NL * NS * 2048;
constexpr size_t O_SIS = O_SIP + (size_t)NL * NB * 2048;
constexpr size_t O_HGP = O_SIS + (size_t)NL * NS * 2048;
constexpr size_t O_HGS = O_HGP + (size_t)NL * NB * 4 * 128 * 128;
constexpr size_t O_GLP = O_HGS + (size_t)NL * NS * 4 * 128 * 128;
constexpr size_t O_GLS = O_GLP + (size_t)NL * NB * 4 * 64 * 128;
constexpr size_t O_CVP = O_GLS + (size_t)NL * NS * 4 * 64 * 128;
constexpr size_t O_CVS = O_CVP + (size_t)NL * NB * 2 * FF;
constexpr size_t O_END = O_CVS + (size_t)NL * NS * 2 * FF;
constexpr size_t al256(size_t x) { return (x + 255) & ~(size_t)255; }
constexpr size_t WS_CTL = 0, CTL_ZERO_BYTES = 1u << 20;
constexpr size_t WS_WIN = CTL_ZERO_BYTES;
constexpr size_t WS_WOUT = WS_WIN + (size_t)NL * INP * D * 2;
constexpr size_t WS_WUP = WS_WOUT + (size_t)NL * D * D * 2;
constexpr size_t WS_WDN = WS_WUP + (size_t)NL * FF2 * D * 2;
constexpr size_t WS_X = WS_WDN + (size_t)NL * D * FF * 2;
constexpr size_t WS_XN = WS_X + (size_t)MPAD * D * 4;
constexpr size_t WS_P = WS_XN + (size_t)MPAD * D * 2;
constexpr size_t WS_MIX = WS_P + (size_t)MPAD * INP * 2;
constexpr size_t WS_SMALL = WS_MIX + (size_t)MPAD * D * 2;
constexpr size_t WS_AB = WS_SMALL, WS_BB = WS_AB + (size_t)NL * 4096 * 4, WS_LB = WS_BB + (size_t)NL * 65536 * 4;
constexpr size_t WS_Y5 = al256(WS_LB + (size_t)NL * 512 * 4);
constexpr size_t WS_HQ = WS_Y5 + (size_t)MPAD * 512 * 2, WS_HK = WS_HQ + (size_t)M * 512 * 4;
constexpr size_t WS_GQ = WS_HK + (size_t)M * 512 * 4, WS_GD = WS_GQ + (size_t)M * 256 * 4;
constexpr size_t WS_OH = WS_GD + (size_t)M * 256 * 4, WS_OG = WS_OH + (size_t)M * 512 * 4;
constexpr size_t WS_OH1 = WS_OG + (size_t)M * 512 * 4;
constexpr size_t WS_GU = WS_OH1 + (size_t)M * 512 * 4;
constexpr size_t WS_GV = WS_GU + (size_t)48 * 65 * 12288;
constexpr size_t WS_WUPT = WS_GV + (size_t)4 * 8 * 65 * 4 * 2048;
constexpr size_t WS_AUPT = WS_WUPT + (size_t)NL * 512 * 64 * 2, WS_GUPT = WS_AUPT + (size_t)NL * 512 * 64 * 2;
constexpr size_t WS_RG = WS_GUPT + (size_t)NL * 512 * 128 * 2;
constexpr size_t WS_RBV = WS_RG + (size_t)M * 512 * 2;
constexpr size_t WS_RY = WS_RBV + (size_t)M * 512 * 4;
constexpr size_t WS_RU = WS_RY + (size_t)M * 512 * 4;
constexpr size_t WS_RV = WS_RU + (size_t)32 * 65 * 20480;
constexpr size_t WS_E5 = WS_RV + (size_t)4 * 8 * 65 * 2 * 2048;
constexpr size_t WS_T5 = WS_E5 + (size_t)NL * 32 * 32768 * 2, WS_G5 = WS_T5 + (size_t)NL * 32 * 65536 * 2, WS_A16 = WS_G5 + (size_t)NL * 32 * 32768 * 2;
constexpr size_t WS_ES = WS_A16 + (size_t)NL * 32 * 128 * 4;
constexpr size_t WS_XS = WS_ES + (size_t)4 * 32 * 160 * 128 * 4;
constexpr size_t WS_WGLUT = WS_XS + (size_t)4 * 32 * 160 * 128 * 2;
constexpr size_t WS_OVL = WS_WGLUT + (size_t)NL * 512 * 512 * 2;
constexpr size_t WS_U = WS_OVL, WS_ACT = WS_U + (size_t)MPAD * FF2 * 2;
constexpr size_t WS_RW = WS_OVL, WS_HS = WS_RW + (size_t)7 * M * 512 * 4;
constexpr size_t WS_END_A = WS_ACT + (size_t)MPAD * FF * 2, WS_END_B = WS_HS + (size_t)2 * M * 2048 * 4;
constexpr size_t WS_RSCR = WS_END_A > WS_END_B ? WS_END_A : WS_END_B;
constexpr size_t WS_SLAB = WS_RSCR + (size_t)2048 * 20480;
constexpr size_t WS_XDUMMY = WS_SLAB + (size_t)256 * 65536 * 4;
constexpr size_t WS_SSQ = WS_XDUMMY + (PROBE_DUP ? (size_t)MPAD * D * 4 : 0);
constexpr size_t WS_SINK = WS_SSQ + (size_t)MPAD * 32 * 4;
constexpr size_t WS_UT = WS_SINK + 4096;
constexpr size_t WS_END = WS_UT + (size_t)NB * 32 * 5 * 16 * 1024;
constexpr int CW_BAR = 4096;
constexpr int RING_OFF = 0, RING_BYTES = 131072;
constexpr int LDSCTL_OFF = RING_BYTES, MISC_OFF = LDSCTL_OFF + 320;
constexpr int LDS_BYTES = 147456;
#define GAS __attribute__((address_space(1)))
#define LAS __attribute__((address_space(3)))
typedef unsigned short bf16;
typedef unsigned v4u __attribute__((ext_vector_type(4)));
typedef unsigned v2u __attribute__((ext_vector_type(2)));
typedef float f32x4 __attribute__((ext_vector_type(4)));
typedef short bf16x8 __attribute__((ext_vector_type(8)));
typedef float f32x16 __attribute__((ext_vector_type(16)));
#define MF32(a, b, c) __builtin_amdgcn_mfma_f32_32x32x16_bf16(a, b, c, 0, 0, 0)
#define LDS_WAIT() asm volatile("s_waitcnt lgkmcnt(0)" ::: "memory")
#define VM_WAIT() asm volatile("s_waitcnt vmcnt(0)" ::: "memory")
__device__ __forceinline__ unsigned f2bf(float f) { unsigned u = __builtin_bit_cast(unsigned, f); return (u + 0x7fffu + ((u >> 16) & 1u)) >> 16; }
__device__ __forceinline__ unsigned pk2(float lo, float hi) { return f2bf(lo) | (f2bf(hi) << 16); }
__device__ __forceinline__ float bf2f(unsigned short b) { return __builtin_bit_cast(float, (unsigned)b << 16); }
__device__ __forceinline__ float bflo(unsigned w) { return __builtin_bit_cast(float, w << 16); }
__device__ __forceinline__ float bfhi(unsigned w) { return __builtin_bit_cast(float, w & 0xffff0000u); }
__device__ __forceinline__ float sigmoidf_(float x) { return 1.f / (1.f + expf(-x)); }
__device__ __forceinline__ float siluf_(float x) { return x * sigmoidf_(x); }
__device__ __forceinline__ float gelu_tanh(float x) { return 0.5f * x * (1.f + tanhf(0.7978845608028654f * (x + 0.044715f * x * x * x))); }
__device__ __forceinline__ float log_sigmoidf_(float x) { return fminf(x, 0.f) - log1pf(expf(-fabsf(x))); }
__device__ __forceinline__ float wave_sum(float v) {
#pragma unroll
    for (int o = 1; o < 64; o <<= 1) v += __shfl_xor(v, o);
    return v;
}
__device__ __forceinline__ void row_seq(int row, int& s, int& t) { if (row < MP) { s = row / TP; t = row % TP; } else { const int r = row - MP; s = NB + r / TS; t = r % TS; } }
__device__ __forceinline__ void seq_rows(int s, int& row0, int& T) { if (s < NB) { row0 = s * TP; T = TP; } else { row0 = MP + (s - NB) * TS; T = TS; } }
namespace pg8 {
__device__ __forceinline__ float gelu_fast2(float x) { const float u = -1.5957691216057308f * (x + 0.044715f * x * x * x); return x * __builtin_amdgcn_rcpf(1.f + __expf(u)); }
template <int CTRL> __device__ __forceinline__ float dpp_f(float x) { return __builtin_bit_cast(float, __builtin_amdgcn_update_dpp(0, __builtin_bit_cast(int, x), CTRL, 0xF, 0xF, true)); }
struct EpiConvAct {
    static constexpr bool PERM = true, AFTER_DRAIN = false;
    bf16_t* ACT; bf16_t* U; const float* cw; const float* cb; float* cvp; const float* ssq;
    __device__ __forceinline__ void operator()(const f32x4 (&acc)[2][2][4][2], const Unit& u, int wr, int wc, int fr, int fq) const {
        const int lane = lane_id();
        const int ffc = u.pn * 128 + wc * 32 + 8 * fq;
        float w0[8], w1[8], w2[8], bb[8];
#pragma unroll
        for (int j = 0; j < 8; j += 4) { const f32x4 a = *(const f32x4*)(cw + ffc + j), b2 = *(const f32x4*)(cw + FF + ffc + j), c = *(const f32x4*)(cw + 2 * FF + ffc + j), d = *(const f32x4*)(cb + ffc + j);
#pragma unroll
            for (int q = 0; q < 4; ++q) { w0[j + q] = a[q]; w1[j + q] = b2[q]; w2[j + q] = c[q]; bb[j + q] = d[q]; } }
        float rsv[2][4];
#pragma unroll
        for (int ai = 0; ai < 2; ++ai)
#pragma unroll
            for (int m = 0; m < 4; ++m) { const int row = u.pm * BM + ai * HALF + wr * 64 + m * 16 + fr; const f32x4* sp = (const f32x4*)(ssq + (size_t)row * 32 + fq * 8); const f32x4 a = sp[0], b2 = sp[1];
                float sq = ((a.x + a.y) + (a.z + a.w)) + ((b2.x + b2.y) + (b2.z + b2.w)); sq += __shfl_xor(sq, 16); sq += __shfl_xor(sq, 32); rsv[ai][m] = rsqrtf(sq * (1.f / D) + EPS); }
#pragma unroll
        for (int ai = 0; ai < 2; ++ai)
#pragma unroll
            for (int m = 0; m < 4; ++m) {
                const int row = u.pm * BM + ai * HALF + wr * 64 + m * 16 + fr;
                float o[8], u0[8], gt[8];
#pragma unroll
                for (int j = 0; j < 8; ++j) {
                    u0[j] = acc[ai][0][m][j >> 2][j & 3] * rsv[ai][m]; gt[j] = acc[ai][1][m][j >> 2][j & 3] * rsv[ai][m];
                    const float p1 = dpp_f<0x111>(u0[j]), p2 = dpp_f<0x112>(u0[j]);
                    float q1 = 0.f, q2 = 0.f;
                    if (m > 0) { const float up = acc[ai][0][m > 0 ? m - 1 : 0][j >> 2][j & 3] * rsv[ai][m > 0 ? m - 1 : 0]; q1 = dpp_f<0x121>(up); q2 = dpp_f<0x122>(up); }
                    const float v1 = fr == 0 ? q1 : p1, v2 = fr < 2 ? q2 : p2;
                    o[j] = gelu_fast2(bb[j] + w0[j] * v2 + w1[j] * v1 + w2[j] * u0[j]) * gt[j];
                }
                u32x4 w; w.x = cvt_pk_bf16(o[0], o[1]); w.y = cvt_pk_bf16(o[2], o[3]); w.z = cvt_pk_bf16(o[4], o[5]); w.w = cvt_pk_bf16(o[6], o[7]);
                *(u32x4*)(ACT + (size_t)row * FF + ffc) = w;
                const int r63 = row & 63; const int t = row < MP ? row % TP : 0;
                if (r63 < 2 || r63 >= 62 || row >= MP - 2 || (row < MP && t < 2)) {
                    u32x4 x; x.x = cvt_pk_bf16(u0[0], u0[1]); x.y = cvt_pk_bf16(u0[2], u0[3]); x.z = cvt_pk_bf16(u0[4], u0[5]); x.w = cvt_pk_bf16(u0[6], u0[7]);
                    u32x4 y; y.x = cvt_pk_bf16(gt[0], gt[1]); y.y = cvt_pk_bf16(gt[2], gt[3]); y.z = cvt_pk_bf16(gt[4], gt[5]); y.w = cvt_pk_bf16(gt[6], gt[7]);
                    *(u32x4*)(U + (size_t)row * FF2 + ffc) = x; *(u32x4*)(U + (size_t)row * FF2 + FF + ffc) = y;
                }
                if (row < MP && t >= TP - 2) { float* bo = cvp + ((size_t)(row / TP) * 2 + (t - (TP - 2))) * FF + ffc;
                    *(f32x4*)bo = (f32x4){u0[0], u0[1], u0[2], u0[3]}; *(f32x4*)(bo + 4) = (f32x4){u0[4], u0[5], u0[6], u0[7]}; }
            }
    }
};
struct ChainOrder {
    StaticOrder s; int mode, c, R, skipc, skipr, vg;
    __device__ __forceinline__ void init(int N_, int G_, int c_, int mode_, int R_, int skipc_, int skipr_, int vg_) { s.init(MA_IN, N_, G_, c_); mode = mode_; c = c_; R = R_; skipc = skipc_; skipr = skipr_; vg = vg_; }
    __device__ __forceinline__ bool unitL(int L, Unit& u) const { StaticOrder t = s; t.c = 0; t.G = 1; if (!t.next(L, u)) return false;
        if (vg) { const int p = u.pn; u.pn = p < 4 ? (p < 2 ? p + 10 : p + 20) : (p == 10 || p == 11) ? p - 10 : (p == 22 || p == 23) ? p - 20 : p; } return true; }
    __device__ __forceinline__ bool next(int i, Unit& u) const {
        constexpr int TR = (MPAD - MA_IN) / 256;
        if (vg) {
            const int Gv = s.G - skipc, nL1 = R * Gv < s.nwg ? R * Gv : s.nwg;
            if (mode == 0) { if (c < skipc || i >= R) return false; const int L = i * Gv + (c - skipc); return L < nL1 && unitL(L, u); }
            int q = i * s.G + c; const int n1 = s.nwg - nL1, nT = TR * s.nN;
            if (q < n1) return unitL(nL1 + q, u);
            q -= n1; if (q >= nT) return false;
            u.pm = MA_IN / 256 + q % TR; u.pn = q / TR; u.k0 = 0; u.nt = 0; u.part = 0; return true;
        }
        if (mode == 0) { const int i2 = i + (c < skipc ? skipr : 0); return i2 < R && s.next(i2, u); }
        const int n1 = s.nwg - R * s.G > 0 ? s.nwg - R * s.G : 0, nS = skipc * skipr, nT = TR * s.nN;
        int q = i * s.G + c;
        if (q < n1) { StaticOrder t = s; t.c = 0; t.G = 1; return t.next(R * s.G + q, u); }
        q -= n1;
        if (q < nS) { StaticOrder t = s; t.c = q % skipc; return t.next(q / skipc, u); }
        q -= nS;
        if (q >= nT) return false;
        u.pm = MA_IN / 256 + q % TR; u.pn = q / TR; u.k0 = 0; u.nt = 0; u.part = 0; return true;
    }
    __device__ __forceinline__ void a_ready(const Unit&) const {}
    __device__ __forceinline__ void done(const Unit&) const {}
};
struct EpiStoreBf16S {
    static constexpr bool PERM = true, AFTER_DRAIN = false;
    bf16_t* O; int ldc; const float* ssq;
    __device__ __forceinline__ void operator()(const f32x4 (&acc)[2][2][4][2], const Unit& u, int wr, int wc, int fr, int fq) const {
        const int row0 = u.pm * BM + wr * 64 + fr, col0 = u.pn * BM + wc * 32 + 8 * fq;
        f32x4 pa[2][4], pb[2][4];
#pragma unroll
        for (int ai = 0; ai < 2; ++ai)
#pragma unroll
            for (int m = 0; m < 4; ++m) { const f32x4* sp = (const f32x4*)(ssq + (size_t)(row0 + ai * HALF + m * 16) * 32 + fq * 8); pa[ai][m] = sp[0]; pb[ai][m] = sp[1]; }
#pragma unroll
        for (int ai = 0; ai < 2; ++ai)
#pragma unroll
            for (int m = 0; m < 4; ++m) { const int row = row0 + ai * HALF + m * 16; bf16_t* rowp = O + (size_t)row * ldc + col0; const f32x4 a = pa[ai][m], b2 = pb[ai][m];
                float sq = ((a.x + a.y) + (a.z + a.w)) + ((b2.x + b2.y) + (b2.z + b2.w)); sq += __shfl_xor(sq, 16); sq += __shfl_xor(sq, 32); const float rs = rsqrtf(sq * (1.f / D) + EPS);
#pragma unroll
                for (int bj = 0; bj < 2; ++bj) { const f32x4 v0 = acc[ai][bj][m][0] * rs, v1 = acc[ai][bj][m][1] * rs;
                    u32x4 w; w.x = cvt_pk_bf16(v0[0], v0[1]); w.y = cvt_pk_bf16(v0[2], v0[3]); w.z = cvt_pk_bf16(v1[0], v1[1]); w.w = cvt_pk_bf16(v1[2], v1[3]);
                    *(u32x4*)(rowp + bj * HALF) = w; } }
    }
};
}
#define XB_TMO      128
#define XB_XCNT(j)  (256  + 64 * (j))
#define XB_XSUB(j)  (1280 + 64 * (j))
#define XB_XGEN(j)  (2304 + 64 * (j))
#define XB_TOP      3328
#define XB_TOPGEN   3392
#define XCD_BAR_WORDS 3456
#define XB_SPIN_CAP (1u << 18)

__device__ __forceinline__ unsigned xb_ld(unsigned* p)              { return __hip_atomic_load(p, __ATOMIC_RELAXED, __HIP_MEMORY_SCOPE_AGENT); }
__device__ __forceinline__ unsigned xb_add(unsigned* p, unsigned v) { return __hip_atomic_fetch_add(p, v, __ATOMIC_RELAXED, __HIP_MEMORY_SCOPE_AGENT); }
__device__ __forceinline__ unsigned xb_xcc_id() { return (unsigned)__builtin_amdgcn_s_getreg((3 << 11) | 20) & 0xFu; }
#define XB_SPIN(cond, bar) do { unsigned _sp = 0; while (cond) { __builtin_amdgcn_s_sleep(1); \
    if ((++_sp & 255u) == 0u) { if (xb_ld(&(bar)[XB_TMO])) break; if (_sp > XB_SPIN_CAP) { atomicAdd(&(bar)[XB_TMO], 1u); break; } } } } while (0)

struct XcdBarrier {
    unsigned* bar; unsigned x; int wv;
    volatile LAS unsigned* st;
};

__device__ __forceinline__ XcdBarrier xcd_barrier_post(unsigned* bar, volatile LAS unsigned* st, int wv) {
    XcdBarrier b; b.bar = bar; b.x = xb_xcc_id(); b.st = st; b.wv = wv;
    if (b.wv == 0 && pg8::lane_id() == 0) (void)xb_add(&bar[XB_XCNT(b.x)], 1u);
    return b;
}
__device__ __forceinline__ void xcd_barrier_complete(unsigned* bar, unsigned x, unsigned& nloc, unsigned& nx) {
    const unsigned G = gridDim.x * gridDim.y * gridDim.z;
    unsigned sum, cnt, mine, sp = 0u;
    for (;;) {
        sum = 0u; cnt = 0u; mine = 0u;
#pragma unroll
        for (unsigned j = 0; j < 16; ++j) { const unsigned c = xb_ld(&bar[XB_XCNT(j)]); sum += c; cnt += (c > 0u) ? 1u : 0u; mine = (j == x) ? c : mine; }
        if (sum == G) break;
        __builtin_amdgcn_s_sleep(1);
        if ((++sp & 255u) == 0u) { if (xb_ld(&bar[XB_TMO])) break; if (sp > XB_SPIN_CAP) { atomicAdd(&bar[XB_TMO], 1u); break; } }
    }
    nloc = mine > 0u ? mine : 1u; nx = cnt > 0u ? cnt : 1u;
}

__device__ __forceinline__ void xcd_barrier(const XcdBarrier& b) {
    asm volatile("s_waitcnt vmcnt(0)" ::: "memory");
    __syncthreads();
    if (b.wv == 0 && pg8::lane_id() == 0) {
        unsigned* bar = b.bar;
        __builtin_amdgcn_s_waitcnt(0);
        unsigned nloc = b.st[0], nx = b.st[1];
        if (nloc == 0u) { xcd_barrier_complete(bar, b.x, nloc, nx); b.st[0] = nloc; b.st[1] = nx; }
        const unsigned old = xb_add(&bar[XB_XSUB(b.x)], 1u);
        const unsigned gen = old / nloc;
        if (old + 1u == (gen + 1u) * nloc) {
            __builtin_amdgcn_fence(__ATOMIC_RELEASE, "agent");
            asm volatile("s_waitcnt vmcnt(0)" ::: "memory");
            const unsigned og = xb_add(&bar[XB_TOP], 1u);
            const unsigned tg = og / nx;
            if (og + 1u == (tg + 1u) * nx) xb_add(&bar[XB_TOPGEN], 1u);
            else XB_SPIN(xb_ld(&bar[XB_TOPGEN]) == tg, bar);
            __builtin_amdgcn_fence(__ATOMIC_ACQUIRE, "agent");
            xb_add(&bar[XB_XGEN(b.x)], 1u);
            asm volatile("s_waitcnt vmcnt(0)" ::: "memory");
        } else {
            XB_SPIN(xb_ld(&bar[XB_XGEN(b.x)]) == gen, bar);
            __builtin_amdgcn_fence(__ATOMIC_ACQUIRE, "agent");
            asm volatile("s_waitcnt vmcnt(0)" ::: "memory");
        }
    }
    __syncthreads();
}
struct Frame {
    LAS unsigned char* lds;
    volatile LAS unsigned* MISC;
    unsigned* ctl;
    int tid, lane, wave, G, gw, NGW;
    const float* const* in; float* out; unsigned char* ws;
};
#define WSP(T, off) ((T*)(F.ws + (off)))
#define GIN(k) ((const float*)(const GAS float*)F.in[(k)])

constexpr int NC5 = 129, NC5P = 160;
__device__ __forceinline__ void s5_consts(Frame& F) {
    LAS float* PW = (LAS float*)(F.lds + RING_OFF);
    LAS float* BBr = PW + 17 * 128; LAS float* BBi = BBr + 1024;
    LAS float* Cr = BBi + 1024; LAS float* Ci = Cr + 1024;
    LAS float* K5 = Ci + 1024;
    for (int it = blockIdx.x; it < NL * 32; it += F.G) {
        const int l = it >> 5, g = it & 31;
        __syncthreads();
        if (F.tid < 64) { const int p = F.tid; const size_t idx = (size_t)l * 2048 + g * 64 + p;
            const float are = GIN(23)[idx], aim = GIN(24)[idx]; const float dt = expf(GIN(25)[l * 32 + g]); const float mag = expf(are * dt);
            const float abr = mag * cosf(aim * dt), abi = mag * sinf(aim * dt); const float den = are * are + aim * aim, nre = abr - 1.f;
            const float cor = (nre * are + abi * aim) / den, coi = (abi * are - nre * aim) / den;
            float pr = 1.f, pi = 0.f;
            for (int tau = 0; tau <= 16; ++tau) { PW[(tau * 64 + p) * 2] = pr; PW[(tau * 64 + p) * 2 + 1] = pi; const float nr = pr * abr - pi * abi, ni = pr * abi + pi * abr; pr = nr; pi = ni; }
            const float* Br = GIN(26) + idx * 16; const float* Bi = GIN(27) + idx * 16;
            for (int c2 = 0; c2 < 16; ++c2) { const float br = Br[c2], bi = Bi[c2]; BBr[p * 16 + c2] = cor * br - coi * bi; BBi[p * 16 + c2] = cor * bi + coi * br; }
        }
        for (int i = F.tid; i < 1024; i += NTHR) { Cr[i] = GIN(28)[(size_t)l * 32768 + g * 1024 + i]; Ci[i] = GIN(29)[(size_t)l * 32768 + g * 1024 + i]; }
        __syncthreads();
        for (int o = F.tid; o < 4096; o += NTHR) { const int tau = o >> 8, c = (o >> 4) & 15, c2 = o & 15; float s = 0.f;
            for (int p = 0; p < 64; ++p) { const float pr = PW[(tau * 64 + p) * 2], pi = PW[(tau * 64 + p) * 2 + 1], br = BBr[p * 16 + c2], bi = BBi[p * 16 + c2];
                const float wr = pr * br - pi * bi, wi = pr * bi + pi * br; s += Cr[c * 64 + p] * wr - Ci[c * 64 + p] * wi; }
            if (tau == 0 && c == c2) s += GIN(30)[(size_t)l * 512 + g * 16 + c];
            K5[o] = s; }
        __syncthreads();
        bf16* T5 = WSP(bf16, WS_T5) + ((size_t)l * 32 + g) * 65536; bf16* E5 = WSP(bf16, WS_E5) + ((size_t)l * 32 + g) * 32768; bf16* G5 = WSP(bf16, WS_G5) + ((size_t)l * 32 + g) * 32768;
        for (int o = F.tid; o < 8192; o += NTHR) { const int rho = o >> 5, k8 = (o & 31) * 8, t = rho >> 4, c = rho & 15, tp = k8 >> 4, c2 = k8 & 15;
            unsigned w[4];
#pragma unroll
            for (int j = 0; j < 8; j += 2) { const float a = tp <= t ? K5[((t - tp) * 16 + c) * 16 + c2 + j] : 0.f, b2 = tp <= t ? K5[((t - tp) * 16 + c) * 16 + c2 + j + 1] : 0.f; w[j >> 1] = pk2(a, b2); }
            *(v4u*)(T5 + (size_t)rho * 256 + k8) = (v4u){w[0], w[1], w[2], w[3]}; }
        for (int o = F.tid; o < 4096; o += NTHR) { const int sg = o >> 5, k8 = (o & 31) * 8, p = sg & 63, im = sg >> 6, tp = k8 >> 4, c2 = k8 & 15;
            const float pr = PW[((15 - tp) * 64 + p) * 2], pi = PW[((15 - tp) * 64 + p) * 2 + 1]; float v[8];
#pragma unroll
            for (int j = 0; j < 8; ++j) { const float br = BBr[p * 16 + c2 + j], bi = BBi[p * 16 + c2 + j]; v[j] = im ? (pr * bi + pi * br) : (pr * br - pi * bi); }
            *(v4u*)(E5 + (size_t)sg * 256 + k8) = (v4u){pk2(v[0], v[1]), pk2(v[2], v[3]), pk2(v[4], v[5]), pk2(v[6], v[7])}; }
        for (int o = F.tid; o < 4096; o += NTHR) { const int rho = o >> 4, s8 = (o & 15) * 8, t = rho >> 4, c = rho & 15, im = s8 >> 6, p0 = s8 & 63; float v[8];
#pragma unroll
            for (int j = 0; j < 8; ++j) { const int p = p0 + j; const float pr = PW[((t + 1) * 64 + p) * 2], pi = PW[((t + 1) * 64 + p) * 2 + 1], cr = Cr[c * 64 + p], ci = Ci[c * 64 + p];
                v[j] = im ? -(cr * pi + ci * pr) : (cr * pr - ci * pi); }
            *(v4u*)(G5 + (size_t)rho * 128 + s8) = (v4u){pk2(v[0], v[1]), pk2(v[2], v[3]), pk2(v[4], v[5]), pk2(v[6], v[7])}; }
        if (F.tid < 64) { float* A16 = WSP(float, WS_A16) + ((size_t)l * 32 + g) * 128; A16[F.tid * 2] = PW[(16 * 64 + F.tid) * 2]; A16[F.tid * 2 + 1] = PW[(16 * 64 + F.tid) * 2 + 1]; }
    }
    __syncthreads();
}
__device__ __forceinline__ void s5_egemm(Frame& F, int l) {
    const bf16* P = WSP(bf16, WS_P); float* ES = WSP(float, WS_ES);
    const int nbusy = RW_ITEMS > F.NGW ? (RW_ITEMS - F.NGW < F.G / 2 ? RW_ITEMS - F.NGW : 0) : 0;
    if ((int)blockIdx.x < nbusy) return;
    for (int it = F.wave * (F.G - nbusy) + ((int)blockIdx.x - nbusy); it < NB * 32 * 5 * 2; it += (F.G - nbusy) * NWAVES) {
        int ln = F.lane; asm volatile("" : "+v"(ln));
        const int mh = it & 1, nt = (it >> 1) % 5, bg = it / 10, b = bg >> 5, g = bg & 31, r = ln & 31, h2 = ln >> 5, n = 32 * nt + r;
        const bf16* E5 = WSP(bf16, WS_E5) + ((size_t)l * 32 + g) * 32768 + (size_t)(64 * mh + r) * 256 + 8 * h2;
        const bool ok = n < NC5; const bf16* up = P + (size_t)(b * TP + 16 * (ok ? n : 0)) * INP + OFF_S + g * 16 + 8 * h2;
        f32x16 acc0, acc1;
#pragma unroll
        for (int e = 0; e < 16; ++e) { acc0[e] = 0.f; acc1[e] = 0.f; }
#pragma unroll
        for (int s4 = 0; s4 < 16; s4 += 8) { bf16x8 bf[8], af0[8], af1[8];
#pragma unroll
            for (int s = 0; s < 8; ++s) { bf[s] = *(const bf16x8*)(up + (size_t)(s4 + s) * INP); af0[s] = *(const bf16x8*)(E5 + 16 * (s4 + s)); af1[s] = *(const bf16x8*)(E5 + 32 * 256 + 16 * (s4 + s)); }
#pragma unroll
            for (int s = 0; s < 8; ++s) { if (!ok) bf[s] = (bf16x8){0, 0, 0, 0, 0, 0, 0, 0}; acc0 = MF32(af0[s], bf[s], acc0); acc1 = MF32(af1[s], bf[s], acc1); }
            if (mh == 0) {
#pragma unroll
                for (int s = 0; s < 8; ++s) *(bf16x8*)(WSP(unsigned char, WS_UT) + ((((size_t)bg * 5 + nt) * 16 + s4 + s) * 64 + ln) * 16) = bf[s]; } }
        float* eo = ES + (((size_t)b * 32 + g) * NC5P + n) * 128 + 64 * mh + 4 * h2;
#pragma unroll
        for (int q = 0; q < 4; ++q) { *(f32x4*)(eo + 8 * q) = (f32x4){acc0[4 * q], acc0[4 * q + 1], acc0[4 * q + 2], acc0[4 * q + 3]}; *(f32x4*)(eo + 32 + 8 * q) = (f32x4){acc1[4 * q], acc1[4 * q + 1], acc1[4 * q + 2], acc1[4 * q + 3]}; }
    }
}
__device__ __forceinline__ void s5_carry(Frame& F, int l, int b, int g) {
    const int p = F.lane; const float* A16 = WSP(float, WS_A16) + ((size_t)l * 32 + g) * 128; const float ar = A16[2 * p], ai = A16[2 * p + 1];
    const float* es = WSP(float, WS_ES) + (((size_t)b * 32 + g) * NC5P) * 128; bf16* xs = WSP(bf16, WS_XS) + (((size_t)b * 32 + g) * NC5P) * 128;
    float xr = 0.f, xi = 0.f;
    for (int c0 = 0; c0 < 132; c0 += 4) {
        float er[4], ei[4];
#pragma unroll
        for (int j = 0; j < 4; ++j) { er[j] = es[(size_t)(c0 + j) * 128 + p]; ei[j] = es[(size_t)(c0 + j) * 128 + 64 + p]; }
#pragma unroll
        for (int j = 0; j < 4; ++j) { if (c0 + j < NC5) { xs[(size_t)(c0 + j) * 128 + p] = (bf16)f2bf(xr); xs[(size_t)(c0 + j) * 128 + 64 + p] = (bf16)f2bf(xi);
            const float nr = ar * xr - ai * xi + er[j], ni = ar * xi + ai * xr + ei[j]; xr = nr; xi = ni; } }
    }
    F.out[O_SRP + ((size_t)l * NB + b) * 2048 + g * 64 + p] = xr; F.out[O_SIP + ((size_t)l * NB + b) * 2048 + g * 64 + p] = xi;
}
__device__ __forceinline__ float gelu_fast_s5(float x) { const float u = -1.5957691216057308f * (x + 0.044715f * x * x * x); return x * __builtin_amdgcn_rcpf(1.f + __expf(u)); }
template <int MH>
__device__ __forceinline__ void s5_ygemm_item(Frame& F, int l, int it) {
    const bf16* P = WSP(bf16, WS_P); bf16* Y5 = WSP(bf16, WS_Y5);
    int ln = F.lane; asm volatile("" : "+v"(ln));
    const int nt = it % 5, bg = it / 5, b = bg >> 5, g = bg & 31, r = ln & 31, h2 = ln >> 5, n = 32 * nt + r;
    const bf16* T5 = WSP(bf16, WS_T5) + ((size_t)l * 32 + g) * 65536; const bf16* G5 = WSP(bf16, WS_G5) + ((size_t)l * 32 + g) * 32768;
    const bool ok = n < NC5; const bf16* up = P + (size_t)(b * TP + 16 * (ok ? n : 0)) * INP + OFF_S + g * 16 + 8 * h2;
    const bf16* xs = WSP(bf16, WS_XS) + (((size_t)b * 32 + g) * NC5P + (ok ? n : 0)) * 128 + 8 * h2;
    f32x16 acc[4];
#pragma unroll
    for (int mm = 0; mm < 4; ++mm)
#pragma unroll
        for (int e = 0; e < 16; ++e) acc[mm][e] = 0.f;
#pragma unroll
    for (int s = 0; s < 14 + 2 * MH; ++s) {
        const bf16x8 bf = *(const bf16x8*)(WSP(unsigned char, WS_UT) + ((((size_t)bg * 5 + nt) * 16 + s) * 64 + ln) * 16);
#pragma unroll
        for (int mm = 0; mm < 4; ++mm) { constexpr int dummy = 0; (void)dummy; const int m = 2 * mm + MH; if (s <= 2 * m + 1) acc[mm] = __builtin_amdgcn_mfma_f32_32x32x16_bf16(*(const bf16x8*)(T5 + (size_t)(32 * m + r) * 256 + 16 * s + 8 * h2), bf, acc[mm], 0, 0, 0); }
    }
#pragma unroll
    for (int s = 0; s < 8; ++s) {
        bf16x8 bf = *(const bf16x8*)(xs + 16 * s);
        if (!ok) bf = (bf16x8){0, 0, 0, 0, 0, 0, 0, 0};
#pragma unroll
        for (int mm = 0; mm < 4; ++mm) { const int m = 2 * mm + MH; acc[mm] = __builtin_amdgcn_mfma_f32_32x32x16_bf16(*(const bf16x8*)(G5 + (size_t)(32 * m + r) * 128 + 16 * s + 8 * h2), bf, acc[mm], 0, 0, 0); }
    }
    if (ok) {
#pragma unroll
        for (int mm = 0; mm < 4; ++mm)
#pragma unroll
            for (int q = 0; q < 4; ++q) { const int m = 2 * mm + MH, t = 2 * m + (q >> 1), c0 = 4 * h2 + 8 * (q & 1);
                v2u w; w.x = pg8::cvt_pk_bf16(gelu_fast_s5(acc[mm][4 * q]), gelu_fast_s5(acc[mm][4 * q + 1])); w.y = pg8::cvt_pk_bf16(gelu_fast_s5(acc[mm][4 * q + 2]), gelu_fast_s5(acc[mm][4 * q + 3]));
                *(v2u*)(Y5 + (size_t)(b * TP + 16 * n + t) * 512 + g * 16 + c0) = w; }
    }
}
__device__ __forceinline__ void s5_ygemm(Frame& F, int l) {
    for (int it = F.gw; it < NB * 32 * 5 * 2; it += F.NGW) { if (it & 1) s5_ygemm_item<1>(F, l, it >> 1); else s5_ygemm_item<0>(F, l, it >> 1); }
}

template <int NIF = 16>
__device__ __forceinline__ void transpose_item(const float* __restrict__ W, int K, int N, bf16* __restrict__ WT, LAS float* scrf, int kb, int nb, int lane, int drow0 = -1, const float* __restrict__ ks = nullptr) {
    LAS unsigned short* scr = (LAS unsigned short*)scrf;
    const int k0 = 64 * kb, n0 = 64 * nb; const int c4 = 4 * (lane & 15), nn = n0 + c4; const bool ok = nn < N; const int d0 = drow0 >= 0 ? drow0 : n0;
#pragma unroll
    for (int hb = 0; hb < 16; hb += NIF) {
        f32x4 vv[NIF];
#pragma unroll
        for (int i = 0; i < NIF; ++i) { const int kk = 4 * (hb + i) + (lane >> 4); vv[i] = (f32x4){0.f, 0.f, 0.f, 0.f}; if (ok) vv[i] = *(const f32x4*)(W + (size_t)(k0 + kk) * N + nn); }
#pragma unroll
        for (int i = 0; i < NIF; ++i) { const int kk = 4 * (hb + i) + (lane >> 4); if (ks) vv[i] = vv[i] * ks[k0 + kk]; *(LAS v2u*)(scr + kk * 66 + c4) = (v2u){pk2(vv[i].x, vv[i].y), pk2(vv[i].z, vv[i].w)}; }
    }
    LDS_WAIT(); asm volatile("" ::: "memory");
    const int c = lane & 7;
#pragma unroll
    for (int i = 0; i < 8; ++i) { const int n = (lane >> 3) + 8 * i; const LAS unsigned short* sp = scr + (8 * c) * 66 + n;
        v4u o; o.x = (unsigned)sp[0] | ((unsigned)sp[66] << 16); o.y = (unsigned)sp[2 * 66] | ((unsigned)sp[3 * 66] << 16); o.z = (unsigned)sp[4 * 66] | ((unsigned)sp[5 * 66] << 16); o.w = (unsigned)sp[6 * 66] | ((unsigned)sp[7 * 66] << 16);
        *(v4u*)(WT + (size_t)(d0 + n) * K + k0 + 8 * c) = o; }
    LDS_WAIT(); asm volatile("" ::: "memory");
}
template <int NIF = 16>
__device__ __forceinline__ void weight_copies(Frame& F, int l, int w0, int wstride, LAS float* scr) {
    constexpr int I_IN = (D / 64) * (INP / 64), I_OUT = (D / 64) * (D / 64), I_UP = (D / 64) * (FF2 / 64), I_DN = (FF / 64) * (D / 64), I_GL = (512 / 64) * (512 / 64), I_L = I_IN + I_OUT + I_UP + I_DN + I_GL;
    for (int it = w0; it < I_L; it += wstride) {
        int r = it;
        if (r < I_IN) { transpose_item<NIF>(GIN(11) + (size_t)l * D * INC, D, INC, WSP(bf16, WS_WIN) + (size_t)l * INP * D, scr, r / (INP / 64), r % (INP / 64), F.lane, -1, GIN(10) + (size_t)l * D); continue; } r -= I_IN;
        if (r < I_OUT) { transpose_item<NIF>(GIN(12) + (size_t)l * D * D, D, D, WSP(bf16, WS_WOUT) + (size_t)l * D * D, scr, r / (D / 64), r % (D / 64), F.lane); continue; } r -= I_OUT;
        if (r < I_UP) { const int nb = r % (FF2 / 64), n0 = 64 * nb;
            const int dr = n0 < FF ? (n0 >> 7) * 256 + (n0 & 127) : ((n0 - FF) >> 7) * 256 + 128 + ((n0 - FF) & 127);
            transpose_item<NIF>(GIN(39) + (size_t)l * D * FF2, D, FF2, WSP(bf16, WS_WUP) + (size_t)l * FF2 * D, scr, r / (FF2 / 64), nb, F.lane, dr, GIN(38) + (size_t)l * D); continue; } r -= I_UP;
        if (r < I_DN) { transpose_item<NIF>(GIN(42) + (size_t)l * FF * D, FF, D, WSP(bf16, WS_WDN) + (size_t)l * D * FF, scr, r / (D / 64), r % (D / 64), F.lane); continue; } r -= I_DN;
        transpose_item<NIF>(GIN(31) + (size_t)l * 512 * 512, 512, 512, WSP(bf16, WS_WGLUT) + (size_t)l * 512 * 512, scr, r / 8, r % 8, F.lane);
    }
}
__device__ __forceinline__ void p0_prologue(Frame& F) {
    s5_consts(F);
    LAS float* scr = (LAS float*)(F.lds + RING_OFF + F.wave * 16384);
    const int nb5 = NL * 32 < F.G ? NL * 32 : 0, V = 2 * nb5 + 3 * (F.G - nb5), v0 = (int)blockIdx.x < nb5 ? 2 * (int)blockIdx.x : 2 * nb5 + 3 * ((int)blockIdx.x - nb5), nv = (int)blockIdx.x < nb5 ? 2 : 3;
    for (int k = 0; k < nv; ++k) weight_copies(F, 0, F.wave * V + v0 + k, V * NWAVES, scr);
    bf16* X = WSP(bf16, WS_X);
    for (int k = 0; k < nv; ++k)
    for (int row = F.wave * V + v0 + k; row < M; row += V * NWAVES) {
        const float* src;
        if (row < MP) { const int b = row / TP, t = row % TP; src = t < NMETA ? GIN(9) + (size_t)t * D : GIN(0) + ((size_t)b * SEQ + (t - NMETA)) * D; }
        else src = GIN(1) + (size_t)(row - MP) * D;
        const f32x4* s4 = (const f32x4*)src; v4u* d8 = (v4u*)(X + (size_t)row * D) + F.lane;
        f32x4 v[8]; float ss = 0.f;
#pragma unroll
        for (int j = 0; j < 4; ++j) { v[2 * j] = s4[(F.lane + 64 * j) * 2]; v[2 * j + 1] = s4[(F.lane + 64 * j) * 2 + 1]; }
#pragma unroll
        for (int j = 0; j < 8; ++j) ss += (v[j].x * v[j].x + v[j].y * v[j].y) + (v[j].z * v[j].z + v[j].w * v[j].w);
#pragma unroll
        for (int j = 0; j < 4; ++j) { v4u w; w.x = pk2(v[2 * j].x, v[2 * j].y); w.y = pk2(v[2 * j].z, v[2 * j].w); w.z = pk2(v[2 * j + 1].x, v[2 * j + 1].y); w.w = pk2(v[2 * j + 1].z, v[2 * j + 1].w); d8[64 * j] = w; }
        const float sst = wave_sum(ss);
        if (F.lane < 32) WSP(float, WS_SSQ)[(size_t)row * 32 + F.lane] = F.lane == 0 ? sst : 0.f;
    }
    { const size_t gt = (size_t)F.gw * 64 + F.lane, GT = (size_t)F.NGW * 64; const v4u z = {0u, 0u, 0u, 0u};
      v4u* sq0 = (v4u*)(WSP(float, WS_SSQ) + (size_t)M * 32); for (size_t i = gt; i < (size_t)(MPAD - M) * 32 / 4; i += GT) sq0[i] = z;
      v4u* ax = (v4u*)(WSP(bf16, WS_X) + (size_t)M * D); for (size_t i = gt; i < (size_t)(MPAD - M) * D / 8; i += GT) ax[i] = z;
      v4u* b = (v4u*)(WSP(bf16, WS_MIX) + (size_t)M * D); for (size_t i = gt; i < (size_t)(MPAD - M) * D / 8; i += GT) b[i] = z;
      v4u* y5 = (v4u*)(WSP(bf16, WS_Y5) + (size_t)M * 512); for (size_t i = gt; i < (size_t)(MPAD - M) * 512 / 8; i += GT) y5[i] = z;
      v4u* c = (v4u*)(WSP(bf16, WS_ACT) + (size_t)M * FF); for (size_t i = gt; i < (size_t)(MPAD - M) * FF / 8; i += GT) c[i] = z;
      float* AB = WSP(float, WS_AB); float* BB = WSP(float, WS_BB); float* LB = WSP(float, WS_LB);
      for (size_t idx = gt; idx < (size_t)NL * 2048; idx += GT) {
          const int l = (int)(idx / 2048), i = (int)(idx % 2048), g = i >> 6;
          const float are = GIN(23)[idx], aim = GIN(24)[idx];
          const float dt = expf(GIN(25)[l * 32 + g]);
          const float mag = expf(are * dt);
          const float abr = mag * cosf(aim * dt), abi = mag * sinf(aim * dt);
          const float den = are * are + aim * aim, nre = abr - 1.f;
          const float cor = (nre * are + abi * aim) / den, coi = (abi * are - nre * aim) / den;
          AB[(size_t)l * 4096 + i] = abr; AB[(size_t)l * 4096 + 2048 + i] = abi;
          const float* Br = GIN(26) + idx * 16; const float* Bi = GIN(27) + idx * 16;
          for (int c2 = 0; c2 < 16; ++c2) { const float br = Br[c2], bi = Bi[c2]; BB[(size_t)l * 65536 + i * 16 + c2] = cor * br - coi * bi; BB[(size_t)l * 65536 + 32768 + i * 16 + c2] = cor * bi + coi * br; }
      }
      { bf16* WU = WSP(bf16, WS_WUPT); bf16* AU = WSP(bf16, WS_AUPT); bf16* GU = WSP(bf16, WS_GUPT);
        for (size_t idx = gt; idx < (size_t)NL * 512 * 64; idx += GT) { const int l2 = (int)(idx / (512 * 64)), col = (int)((idx / 64) % 512), k2 = (int)(idx % 64);
            WU[idx] = (bf16)f2bf(GIN(15)[((size_t)l2 * 64 + k2) * 512 + col]); AU[idx] = (bf16)f2bf(GIN(17)[((size_t)l2 * 64 + k2) * 512 + col]); }
        for (size_t idx = gt; idx < (size_t)NL * 512 * 128; idx += GT) { const int l2 = (int)(idx / (512 * 128)), col = (int)((idx / 128) % 512), k2 = (int)(idx % 128);
            GU[idx] = (bf16)f2bf(GIN(18)[((size_t)l2 * 128 + k2) * 512 + col]); } }
      for (size_t c2 = gt; c2 < 512; c2 += GT) {
          const float* lr = GIN(33); float mx = -1e30f;
#pragma unroll
          for (int l = 0; l < NL; ++l) mx = fmaxf(mx, lr[l * 512 + c2]);
          float sum = 0.f;
#pragma unroll
          for (int l = 0; l < NL; ++l) sum += expf(lr[l * 512 + c2] - mx);
          const float e0 = expf(lr[c2] - mx) / sum; float cum = 0.f;
#pragma unroll
          for (int l = 0; l < NL; ++l) { cum += expf(lr[l * 512 + c2] - mx) / sum; LB[l * 512 + c2] = cum - e0; }
      }
    }
}

__device__ __forceinline__ void slab_table(Frame& F, int KS, pg8::SplitTailOrder& S) {
    LAS int* tab = (LAS int*)(F.lds + RING_OFF);
    S.init2(MPAD, D, KS, F.G, 0);
    __syncthreads();
    for (int i = F.tid; i < (MPAD / 256) * 8; i += NTHR) tab[i] = -1;
    __syncthreads();
    if (F.tid < S.rem) { pg8::StaticOrder t = S; t.c = F.tid; pg8::Unit u; if (t.next(S.full, u)) tab[u.pm * 8 + u.pn] = F.tid * S.P; }
    __syncthreads();
}
__device__ __forceinline__ void unpack8(const v4u a, float (&o)[8]);
__device__ __forceinline__ v4u pack8(const float (&o)[8]) { v4u w; w.x = pg8::cvt_pk_bf16(o[0], o[1]); w.y = pg8::cvt_pk_bf16(o[2], o[3]); w.z = pg8::cvt_pk_bf16(o[4], o[5]); w.w = pg8::cvt_pk_bf16(o[6], o[7]); return w; }
__device__ __forceinline__ void load_xrow(bf16* __restrict__ X, int row, int lane, bool fold, const LAS int* tab, const float* slab, int SP, bool wb, float (&v)[4][8]) {
    v4u* xr = (v4u*)(X + (size_t)row * D) + lane;
    v4u raw[4];
#pragma unroll
    for (int j = 0; j < 4; ++j) raw[j] = xr[64 * j];
#pragma unroll
    for (int j = 0; j < 4; ++j) unpack8(raw[j], v[j]);
    if (fold) {
#pragma unroll
        for (int j = 0; j < 4; ++j) { const int sb = tab[(row >> 8) * 8 + 2 * j + (lane >> 5)];
            if (sb >= 0) { const bf16* sp = (const bf16*)slab + (size_t)sb * 65536 + (size_t)(row & 255) * 256 + 8 * (lane & 31);
                for (int p = 0; p < SP; ++p) { float a[8]; unpack8(*(const v4u*)(sp + (size_t)p * 65536), a);
#pragma unroll
                    for (int e = 0; e < 8; ++e) v[j][e] += a[e]; }
                const v4u w = pack8(v[j]); unpack8(w, v[j]); if (wb) xr[64 * j] = w; } }
    }
}
__device__ __forceinline__ void norm_rows(Frame& F, bf16* __restrict__ X, const float* __restrict__ g, bf16* __restrict__ XN, int KS) {
    pg8::SplitTailOrder S; const LAS int* tab = (const LAS int*)(F.lds + RING_OFF); const float* slab = WSP(float, WS_SLAB);
    if (KS) slab_table(F, KS, S);
    for (int row = F.gw; row < M; row += F.NGW) {
        float v[4][8]; load_xrow(X, row, F.lane, KS != 0, tab, slab, S.P, true, v);
        float s = 0.f;
#pragma unroll
        for (int j = 0; j < 4; ++j)
#pragma unroll
            for (int e = 0; e < 8; ++e) s += v[j][e] * v[j][e];
        const float r = rsqrtf(wave_sum(s) * (1.f / D) + EPS);
        v4u* o8 = (v4u*)(XN + (size_t)row * D) + F.lane;
#pragma unroll
        for (int j = 0; j < 4; ++j) { const f32x4 g0 = ((const f32x4*)g)[(F.lane + 64 * j) * 2], g1 = ((const f32x4*)g)[(F.lane + 64 * j) * 2 + 1];
            float o[8] = {v[j][0] * r * g0.x, v[j][1] * r * g0.y, v[j][2] * r * g0.z, v[j][3] * r * g0.w, v[j][4] * r * g1.x, v[j][5] * r * g1.y, v[j][6] * r * g1.z, v[j][7] * r * g1.w};
            o8[64 * j] = pack8(o); }
    }
    if (KS) __syncthreads();
}
__device__ __forceinline__ void final_rows(Frame& F, bf16* __restrict__ X, const float* __restrict__ g, float* __restrict__ out) {
    pg8::SplitTailOrder S; const LAS int* tab = (const LAS int*)(F.lds + RING_OFF); const float* slab = WSP(float, WS_SLAB);
    slab_table(F, FF, S);
    for (int row = F.gw; row < M; row += F.NGW) {
        float* o;
        if (row < MP) { const int b = row / TP, t = row % TP; if (t < NMETA) continue; o = out + O_YP + ((size_t)b * SEQ + (t - NMETA)) * D; }
        else o = out + O_YS + (size_t)(row - MP) * D;
        float v[4][8]; load_xrow(X, row, F.lane, true, tab, slab, S.P, false, v);
        float s = 0.f;
#pragma unroll
        for (int j = 0; j < 4; ++j)
#pragma unroll
            for (int e = 0; e < 8; ++e) s += v[j][e] * v[j][e];
        const float r = rsqrtf(wave_sum(s) * (1.f / D) + EPS);
        f32x4* o4 = (f32x4*)o;
#pragma unroll
        for (int j = 0; j < 4; ++j) { const f32x4 g0 = ((const f32x4*)g)[(F.lane + 64 * j) * 2], g1 = ((const f32x4*)g)[(F.lane + 64 * j) * 2 + 1];
            f32x4 a = {v[j][0] * r * g0.x, v[j][1] * r * g0.y, v[j][2] * r * g0.z, v[j][3] * r * g0.w}, b2 = {v[j][4] * r * g1.x, v[j][5] * r * g1.y, v[j][6] * r * g1.z, v[j][7] * r * g1.w};
            o4[(F.lane + 64 * j) * 2] = a; o4[(F.lane + 64 * j) * 2 + 1] = b2; }
    }
}

__device__ __forceinline__ void mix_pre(Frame& F, int l) {
    LAS float* ps = (LAS float*)(F.lds + RING_OFF);
    LAS float* lo = ps + RC;
    LAS float* kkn = lo + 256;
    const bf16* P = WSP(bf16, WS_P);
    const float* shift_in = GIN(3) + (size_t)l * NS * RC; const float* mu = GIN(13) + (size_t)l * RC;
    const float* w0 = GIN(14) + (size_t)l * 512; const float* w_up = GIN(15) + (size_t)l * 64 * 512;
    const float* a0 = GIN(16) + (size_t)l * 512; const float* a_up = GIN(17) + (size_t)l * 64 * 512; const float* g_up = GIN(18) + (size_t)l * 128 * 512;
    const float* k_k = GIN(19) + (size_t)l * 512; const float* k_a = GIN(20) + (size_t)l * 512;
    float* shp = F.out + O_SHP + (size_t)l * NB * RC; float* shs = F.out + O_SHS + (size_t)l * NS * RC;
    float* RW = WSP(float, WS_RW); const size_t st = (size_t)M * 512;
    const float* lb = WSP(float, WS_LB) + (size_t)l * 512;
    float* HQ = WSP(float, WS_HQ); float* HK = WSP(float, WS_HK); float* GQ = WSP(float, WS_GQ); float* GD = WSP(float, WS_GD);
    const float* gk_up = GIN(35) + (size_t)l * 16 * 256; const float* gk_b = GIN(36) + (size_t)l * 256;
    if (blockIdx.x < NB) { const bf16* pl = P + (size_t)(blockIdx.x * TP + TP - 1) * INP; for (int i = F.tid; i < RC; i += NTHR) shp[(size_t)blockIdx.x * RC + i] = bf2f(pl[i]); }
    const int nbusy = RW_ITEMS > F.NGW ? (RW_ITEMS - F.NGW < F.G / 2 ? RW_ITEMS - F.NGW : 0) : 0;
    static_assert(MS == NS * TS && TS == 4, "sample sequences of 4 rows");
    LAS float* lo4 = ps + TS * RC;
    LAS float* kk4 = lo4 + TS * 256;
    for (int sq = (int)blockIdx.x - nbusy; (int)blockIdx.x >= nbusy && sq < NS; sq += F.G - nbusy) {
        const int row0 = MP + sq * TS; const bf16* p0 = P + (size_t)row0 * INP;
        __syncthreads();
        for (int i = F.tid; i < RC; i += NTHR) {
            float prev = shift_in[(size_t)sq * RC + i]; const float m = mu[i];
            float cur4[TS];
#pragma unroll
            for (int q = 0; q < TS; ++q) cur4[q] = bf2f(p0[(size_t)q * INP + i]);
#pragma unroll
            for (int q = 0; q < TS; ++q) { ps[q * RC + i] = cur4[q] + (prev - cur4[q]) * m; prev = cur4[q]; }
            shs[(size_t)sq * RC + i] = prev;
        }
        __syncthreads();
        for (int e = F.tid; e < TS * 256; e += NTHR) { const int q = e >> 8, i = e & 255; const LAS float* pq = ps + q * RC; float v; if (i < 64) v = tanhf(pq[1536 + i]); else if (i < 128) v = pq[1536 + i]; else v = sigmoidf_(pq[1664 + (i - 128)]); lo4[q * 256 + i] = v; }
        __syncthreads();
        const int c = F.tid;
        float lw[TS], la[TS], g[TS];
#pragma unroll
        for (int q = 0; q < TS; ++q) { lw[q] = w0[c]; la[q] = a0[c]; g[q] = 0.f; }
        { const bf16* wu = WSP(bf16, WS_WUPT) + ((size_t)l * 512 + c) * 64; const bf16* au = WSP(bf16, WS_AUPT) + ((size_t)l * 512 + c) * 64; const bf16* gu = WSP(bf16, WS_GUPT) + ((size_t)l * 512 + c) * 128;
#pragma unroll 1
          for (int q8 = 0; q8 < 8; ++q8) { float a8[8], b8[8]; unpack8(*(const v4u*)(wu + 8 * q8), a8); unpack8(*(const v4u*)(au + 8 * q8), b8);
#pragma unroll
              for (int q = 0; q < TS; ++q)
#pragma unroll
                  for (int j = 0; j < 8; ++j) { lw[q] += lo4[q * 256 + 8 * q8 + j] * a8[j]; la[q] += lo4[q * 256 + 64 + 8 * q8 + j] * b8[j]; } }
#pragma unroll 1
          for (int q8 = 0; q8 < 16; ++q8) { float a8[8]; unpack8(*(const v4u*)(gu + 8 * q8), a8);
#pragma unroll
              for (int q = 0; q < TS; ++q)
#pragma unroll
                  for (int j = 0; j < 8; ++j) g[q] += lo4[q * 256 + 128 + 8 * q8 + j] * a8[j]; } }
        float kkv[TS], av[TS];
        const float kkc = k_k[c], kac = k_a[c];
#pragma unroll
        for (int q = 0; q < TS; ++q) { const LAS float* pq = ps + q * RC;
            const float w = expf(-0.606531f * sigmoidf_(lw[q])), a = sigmoidf_(la[q]), k = pq[512 + c];
            const float kk = k * kkc; const size_t o = (size_t)(row0 + q) * 512 + c;
            RW[0 * st + o] = pq[c]; RW[1 * st + o] = w; RW[2 * st + o] = k * (1.f + (a - 1.f) * kac); RW[3 * st + o] = pq[1024 + c]; RW[6 * st + o] = g[q];
            const float ss = wave_sum(kk * kk);
            if (F.lane == 0) kk4[q * 8 + F.wave] = ss;
            kkv[q] = kk; av[q] = a; }
        __syncthreads();
        float gku[16]; const float gkb = c < 256 ? gk_b[c] : 0.f; const float lbc = lb[c];
        if (c < 256) {
#pragma unroll
            for (int j = 0; j < 16; ++j) gku[j] = gk_up[j * 256 + c]; }
#pragma unroll
        for (int q = 0; q < TS; ++q) { const bf16* pr = p0 + (size_t)q * INP; const size_t o = (size_t)(row0 + q) * 512 + c;
            const float kk = kkv[q] / fmaxf(sqrtf(kk4[q * 8 + (c >> 6)]), 1e-12f);
            RW[4 * st + o] = kk; RW[5 * st + o] = kk * av[q];
            HQ[o] = siluf_(bf2f(pr[OFF_H + c]));
            HK[o] = fminf((1.f - lbc) * sigmoidf_(-bf2f(pr[OFF_H + 512 + c])), 1.f - 1e-4f);
            if (c < 256) { float x = gkb;
#pragma unroll
                for (int j = 0; j < 16; ++j) x += bf2f(pr[OFF_G + 1024 + j]) * gku[j];
                GQ[(size_t)(row0 + q) * 256 + c] = bf2f(pr[OFF_G + c]) * 0.125f; GD[(size_t)(row0 + q) * 256 + c] = expf(log_sigmoidf_(x) * (1.f / 16.f)); } }
    }
}

__device__ __forceinline__ void scan_rwkv(Frame& F, int l, int s, int h, LAS float* scr) {
    const int v = F.lane; int row0, T; seq_rows(s, row0, T);
    const float* RW = WSP(float, WS_RW); const size_t st = (size_t)M * 512;
    float S[64];
    if (s < NB) {
#pragma unroll
        for (int k = 0; k < 64; ++k) S[k] = 0.f;
    } else { const f32x4* si = (const f32x4*)(GIN(2) + ((((size_t)l * NS + (s - NB)) * 8 + h) * 64 + v) * 64);
#pragma unroll
        for (int k = 0; k < 16; ++k) { const f32x4 q = si[k]; S[4 * k] = q.x; S[4 * k + 1] = q.y; S[4 * k + 2] = q.z; S[4 * k + 3] = q.w; } }
    const float rk = GIN(21)[(size_t)l * 512 + h * 64 + v], lg = GIN(22)[(size_t)l * 512 + h * 64 + v];
    bf16* MIX = WSP(bf16, WS_MIX);
    for (int t = 0; t < T; ++t) {
        const size_t o = (size_t)(row0 + t) * 512 + h * 64 + v;
        const float r_ = RW[0 * st + o], w_ = RW[1 * st + o], k_ = RW[2 * st + o], v_ = RW[3 * st + o], kk_ = RW[4 * st + o], ka_ = RW[5 * st + o], g_ = RW[6 * st + o];
        asm volatile("" ::: "memory");
        scr[v] = r_; scr[64 + v] = w_; scr[128 + v] = k_; scr[192 + v] = kk_; scr[256 + v] = ka_;
        LDS_WAIT();
        float sa = 0.f;
#pragma unroll
        for (int k = 0; k < 64; ++k) sa += S[k] * scr[192 + k];
        float y = 0.f;
#pragma unroll
        for (int k = 0; k < 64; ++k) { S[k] = S[k] * scr[64 + k] - sa * scr[256 + k] + v_ * scr[128 + k]; y += S[k] * scr[k]; }
        const float mean = wave_sum(y) * (1.f / 64.f), d = y - mean;
        const float var = wave_sum(d * d) * (1.f / 64.f);
        float yo = d * rsqrtf(var + 64e-5f) * lg;
        yo += wave_sum(r_ * k_ * rk) * v_;
        MIX[(size_t)(row0 + t) * D + h * 64 + v] = (bf16)f2bf(yo * g_);
    }
    float* so = (s < NB) ? F.out + O_RWP + ((((size_t)l * NB + s) * 8 + h) * 64 + v) * 64 : F.out + O_RWS + ((((size_t)l * NS + (s - NB)) * 8 + h) * 64 + v) * 64;
#pragma unroll
    for (int k = 0; k < 16; ++k) ((f32x4*)so)[k] = (f32x4){S[4 * k], S[4 * k + 1], S[4 * k + 2], S[4 * k + 3]};
}
__device__ __forceinline__ void scan_s5(Frame& F, int l, int s, int g) {
    const int p = F.lane, i = g * 64 + p; int row0, T; seq_rows(s, row0, T);
    const float* AB = WSP(float, WS_AB) + (size_t)l * 4096; const float* BB = WSP(float, WS_BB) + (size_t)l * 65536;
    const float abr = AB[i], abi = AB[2048 + i];
    float br[16], bi[16];
#pragma unroll
    for (int c = 0; c < 16; ++c) { br[c] = BB[i * 16 + c]; bi[c] = BB[32768 + i * 16 + c]; }
    float hr = 0.f, hi = 0.f;
    if (s >= NB) { hr = GIN(4)[((size_t)l * NS + (s - NB)) * 2048 + i]; hi = GIN(5)[((size_t)l * NS + (s - NB)) * 2048 + i]; }
    float* HS = WSP(float, WS_HS); const size_t st = (size_t)M * 2048; const bf16* P = WSP(bf16, WS_P);
    for (int t = 0; t < T; ++t) {
        const v4u* u8 = (const v4u*)(P + (size_t)(row0 + t) * INP + OFF_S + g * 16);
        const v4u ua = u8[0], ub = u8[1];
        const float u[16] = {bflo(ua.x), bfhi(ua.x), bflo(ua.y), bfhi(ua.y), bflo(ua.z), bfhi(ua.z), bflo(ua.w), bfhi(ua.w), bflo(ub.x), bfhi(ub.x), bflo(ub.y), bfhi(ub.y), bflo(ub.z), bfhi(ub.z), bflo(ub.w), bfhi(ub.w)};
        float bur = 0.f, bui = 0.f;
#pragma unroll
        for (int c = 0; c < 16; ++c) { bur += br[c] * u[c]; bui += bi[c] * u[c]; }
        const float nr = abr * hr - abi * hi + bur, ni = abr * hi + abi * hr + bui;
        hr = nr; hi = ni;
        HS[(size_t)(row0 + t) * 2048 + i] = hr; HS[st + (size_t)(row0 + t) * 2048 + i] = hi;
    }
    if (s < NB) { F.out[O_SRP + ((size_t)l * NB + s) * 2048 + i] = hr; F.out[O_SIP + ((size_t)l * NB + s) * 2048 + i] = hi; }
    else { F.out[O_SRS + ((size_t)l * NS + (s - NB)) * 2048 + i] = hr; F.out[O_SIS + ((size_t)l * NS + (s - NB)) * 2048 + i] = hi; }
}
template <int KD, bool IS_HGRN>
__device__ __forceinline__ void scan_glr(Frame& F, int l, int s, int h, int vb, LAS float* scr) {
    const int v = vb * 64 + F.lane; int row0, T; seq_rows(s, row0, T);
    const bf16* P = WSP(bf16, WS_P);
    const float* Q = IS_HGRN ? WSP(float, WS_HQ) : WSP(float, WS_GQ); const float* X2 = IS_HGRN ? WSP(float, WS_HK) : WSP(float, WS_GD);
    bf16* ORAW = IS_HGRN ? WSP(bf16, WS_OH) : WSP(bf16, WS_OG);
    constexpr int QW = 4 * KD;
    float S[KD];
    if (s < NB) {
#pragma unroll
        for (int k = 0; k < KD; ++k) S[k] = 0.f;
    } else { const float* si = (IS_HGRN ? GIN(6) : GIN(7)) + (((size_t)l * NS + (s - NB)) * 4 + h) * KD * 128 + v;
#pragma unroll
        for (int k = 0; k < KD; ++k) S[k] = si[(size_t)k * 128]; }
    LAS float* vq = scr; LAS float* vd = scr + KD; LAS float* vk = scr + 2 * KD;
    for (int t = 0; t < T; ++t) {
        const int row = row0 + t;
        asm volatile("" ::: "memory");
#pragma unroll
        for (int k = F.lane; k < KD; k += 64) {
            const float q = Q[(size_t)row * QW + h * KD + k], x2 = X2[(size_t)row * QW + h * KD + k];
            vq[k] = q;
            if (IS_HGRN) { vd[k] = 1.f - x2; vk[k] = x2; } else { vd[k] = x2; vk[k] = bf2f(P[(size_t)row * INP + OFF_G + 256 + h * 64 + k]); }
        }
        const float val = IS_HGRN ? bf2f(P[(size_t)row * INP + OFF_H + 1024 + h * 128 + v]) : bf2f(P[(size_t)row * INP + OFF_G + 512 + h * 128 + v]);
        LDS_WAIT();
        float o = 0.f;
#pragma unroll
        for (int k = 0; k < KD; ++k) { S[k] = vd[k] * S[k] + vk[k] * val; o += vq[k] * S[k]; }
        ORAW[(size_t)row * 512 + h * 128 + v] = (bf16)f2bf(o);
    }
    float* so = IS_HGRN ? ((s < NB) ? F.out + O_HGP + (((size_t)l * NB + s) * 4 + h) * KD * 128 + v : F.out + O_HGS + (((size_t)l * NS + (s - NB)) * 4 + h) * KD * 128 + v)
                        : ((s < NB) ? F.out + O_GLP + (((size_t)l * NB + s) * 4 + h) * KD * 128 + v : F.out + O_GLS + (((size_t)l * NS + (s - NB)) * 4 + h) * KD * 128 + v);
#pragma unroll
    for (int k = 0; k < KD; ++k) so[(size_t)k * 128] = S[k];
}
constexpr int NCH = 65;
constexpr int UB_QT = 0, UB_KT = 4096, UB_AI = 8192, UB_DT = 10240, UB_AT = 12288, UB_BT = 16384;
constexpr int UBG = 12288, UBR = 20480;
constexpr int NU_H = NB * 4 * 2, NU_G = NB * 4, NU_GLR = NU_H + NU_G;
typedef float f32x2v_ __attribute__((ext_vector_type(2)));
typedef __bf16 bf16x2v_ __attribute__((ext_vector_type(2)));
__device__ __forceinline__ unsigned cvtpk(float lo, float hi) { const f32x2v_ v = {lo, hi}; const bf16x2v_ b = __builtin_convertvector(v, bf16x2v_); return __builtin_bit_cast(unsigned, b); }

__device__ __forceinline__ void glr_pre_item(Frame& F, int l, int isG, int b, int hh, int c) {
    LAS float* OS = (LAS float*)(F.lds + RING_OFF);
    LAS unsigned short* QTL = (LAS unsigned short*)(F.lds + RING_OFF + 2048);
    LAS unsigned short* QM = (LAS unsigned short*)(F.lds + RING_OFF + 2048 + 8192);
    LAS unsigned short* KM = QM + 32 * 136;
    LAS unsigned short* QX = KM + 32 * 136;
    LAS unsigned short* KX = QX + 16 * 136;
    const bf16* P = WSP(bf16, WS_P);
    const int kc = F.tid & 127, q = F.tid >> 7, un = kc >> 6, kl = kc & 63;
    const int head = isG ? 2 * hh + un : hh;
    const int unit = isG ? NU_H + b * 4 + head : (b * 4 + hh) * 2 + un;
    unsigned char* ub = F.ws + WS_GU + ((size_t)unit * NCH + c) * UBG;
    float qs[8], kin[8], bc[8];
    const float lbv = isG ? 0.f : WSP(float, WS_LB)[(size_t)l * 512 + hh * 128 + kc];
    const float gkb = isG ? GIN(36)[(size_t)l * 256 + head * 64 + kl] : 0.f;
    float gku[16];
    if (isG) {
#pragma unroll
        for (int j = 0; j < 16; ++j) gku[j] = GIN(35)[((size_t)l * 16 + j) * 256 + head * 64 + kl];
    }
    float run = 0.f;
#pragma unroll
    for (int i = 0; i < 8; ++i) {
        const int t = 32 * c + 8 * q + i; const bool ok = t < TP;
        const bf16* p = P + (size_t)(b * TP + (ok ? t : 0)) * INP;
        float qv, kv, ld;
        if (!isG) { const float q0 = bf2f(p[OFF_H + hh * 128 + kc]); qv = q0 * __builtin_amdgcn_rcpf(1.f + __expf(-q0)); kv = fminf((1.f - lbv) * __builtin_amdgcn_rcpf(1.f + __expf(bf2f(p[OFF_H + 512 + hh * 128 + kc]))), 1.f - 1e-4f); ld = __logf(1.f - kv); }
        else { qv = bf2f(p[OFF_G + head * 64 + kl]) * 0.125f; kv = bf2f(p[OFF_G + 256 + head * 64 + kl]);
            const v4u g0 = *(const v4u*)(p + OFF_G + 1024), g1 = *(const v4u*)(p + OFF_G + 1032);
            float x = gkb;
            x += bflo(g0.x) * gku[0] + bfhi(g0.x) * gku[1] + bflo(g0.y) * gku[2] + bfhi(g0.y) * gku[3] + bflo(g0.z) * gku[4] + bfhi(g0.z) * gku[5] + bflo(g0.w) * gku[6] + bfhi(g0.w) * gku[7];
            x += bflo(g1.x) * gku[8] + bfhi(g1.x) * gku[9] + bflo(g1.y) * gku[10] + bfhi(g1.y) * gku[11] + bflo(g1.z) * gku[12] + bfhi(g1.z) * gku[13] + bflo(g1.w) * gku[14] + bfhi(g1.w) * gku[15];
            ld = (fminf(x, 0.f) - __logf(1.f + __expf(-fabsf(x)))) * (1.f / 16.f); }
        if (!ok) { qv = 0.f; kv = 0.f; ld = 0.f; }
        run += ld; qs[i] = qv; kin[i] = kv; bc[i] = run;
    }
    __syncthreads();
    OS[q * 128 + kc] = run;
    __syncthreads();
    const float o0 = OS[kc], o1 = OS[128 + kc], o2 = OS[256 + kc], o3 = OS[384 + kc];
    const float r7 = o0, r15 = o0 + o1, r23 = r15 + o2, r31 = r23 + o3;
    const float pre = q == 0 ? 0.f : (q == 1 ? r7 : (q == 2 ? r15 : r23));
    const float rblk = q < 2 ? r7 : r23;
    unsigned kt[4];
#pragma unroll
    for (int i = 0; i < 8; i += 2) {
        const float b0 = bc[i] + pre, b1 = bc[i + 1] + pre;
        kt[i >> 1] = pk2(kin[i] * __expf(r31 - b0), kin[i + 1] * __expf(r31 - b1));
    }
    { const int m = kl >> 5, r = kl & 31, s2 = q >> 1, h2 = q & 1;
      *(v4u*)(ub + UB_KT + (((m * 2 + s2) * 2 + h2) * 32 + r) * 16) = (v4u){kt[0], kt[1], kt[2], kt[3]}; }
    if (q == 3) *(float*)(ub + UB_DT + kl * 4) = __expf(r31);
#pragma unroll
    for (int i = 0; i < 8; ++i) {
        const int t = 8 * q + i; const float bt = bc[i] + pre;
        { const int s = kl >> 4, h2 = (kl >> 2) & 1, j = ((kl >> 3) & 1) * 4 + (kl & 3);
          QTL[un * 2048 + ((s * 2 + h2) * 32 + t) * 8 + j] = (unsigned short)f2bf(qs[i] * __expf(bt)); }
        QM[t * 136 + kc] = (unsigned short)f2bf(qs[i] * __expf(bt - rblk));
        KM[t * 136 + kc] = (unsigned short)f2bf(kin[i] * __expf(rblk - bt));
        if (q >= 2) QX[(t - 16) * 136 + kc] = (unsigned short)f2bf(qs[i] * __expf(bt - r15));
        else KX[t * 136 + kc] = (unsigned short)f2bf(kin[i] * __expf(r15 - bt));
    }
    for (int pass = 0; pass < (isG ? 2 : 1); ++pass) {
        const int vcol = kc + 128 * pass, hd = isG ? 2 * hh + (vcol >> 7) : hh, v = vcol & 127;
        unsigned w[4];
#pragma unroll
        for (int i = 0; i < 8; i += 2) {
            const int t = 32 * c + 8 * q + i;
            const bf16* p0 = P + (size_t)(b * TP + (t < TP ? t : 0)) * INP; const bf16* p1 = P + (size_t)(b * TP + (t + 1 < TP ? t + 1 : 0)) * INP;
            const int off = isG ? OFF_G + 512 + hd * 128 + v : OFF_H + 1024 + hd * 128 + v;
            const unsigned a0 = t < TP ? p0[off] : 0u, a1 = t + 1 < TP ? p1[off] : 0u;
            w[i >> 1] = a0 | (a1 << 16);
        }
        unsigned char* vt = F.ws + WS_GV + ((((size_t)b * 8 + (isG ? 4 : 0) + hd) * NCH + c) * 4 + (v >> 5)) * 2048;
        *(v4u*)(vt + (((q >> 1) * 2 + (q & 1)) * 32 + (v & 31)) * 16) = (v4u){w[0], w[1], w[2], w[3]};
    }
    __syncthreads();
    { const int u2 = F.tid >> 8, o16 = F.tid & 255;
      const int unit2 = isG ? NU_H + b * 4 + 2 * hh + u2 : (b * 4 + hh) * 2 + u2;
      *(v4u*)(F.ws + WS_GU + ((size_t)unit2 * NCH + c) * UBG + UB_QT + o16 * 16) = *(const LAS v4u*)((const LAS unsigned char*)QTL + u2 * 4096 + o16 * 16); }
    { const int w4 = F.wave & 3, grp = F.wave >> 2;
      if (isG || grp == 0) {
          const int k0 = isG ? 64 * grp : 0, nks = isG ? 2 : 4;
          const int hdA = isG ? 2 * hh + grp : hh;
          const int unitA = isG ? NU_H + b * 4 + hdA : (b * 4 + hh) * 2;
          unsigned char* ai = F.ws + WS_GU + ((size_t)unitA * NCH + c) * UBG + UB_AI;
          const int rr = F.lane & 15, kg = F.lane >> 4;
          if (w4 < 3) {
              const int bi = w4 == 0 ? 0 : 1, bj = w4 == 1 ? 1 : 0;
              const LAS unsigned short* qa = (w4 == 2 ? QX + rr * 136 : QM + (16 * bi + rr) * 136) + k0 + 8 * kg;
              const LAS unsigned short* kb = (w4 == 2 ? KX + rr * 136 : KM + (16 * bj + rr) * 136) + k0 + 8 * kg;
              f32x4 acc = {0.f, 0.f, 0.f, 0.f};
              for (int ks = 0; ks < nks; ++ks) acc = __builtin_amdgcn_mfma_f32_16x16x32_bf16(*(const LAS bf16x8*)(qa + 32 * ks), *(const LAS bf16x8*)(kb + 32 * ks), acc, 0, 0, 0);
              const int jj = rr;
#pragma unroll
              for (int e = 0; e < 4; ++e) { const int ii = 4 * kg + e; float val = acc[e]; if (w4 < 2 && jj > ii) val = 0.f;
                  const int t = 16 * bi + ii, tp = 16 * bj + jj;
                  *(unsigned short*)(ai + (((tp >> 4) * 2 + ((tp >> 3) & 1)) * 32 + t) * 16 + (tp & 7) * 2) = (unsigned short)f2bf(val); }
          } else if (F.lane < 32) {
              const int t = F.lane & 15, h2 = F.lane >> 4;
              unsigned z0 = 0u; asm volatile("" : "+v"(z0)); *(v4u*)(ai + ((1 * 2 + h2) * 32 + t) * 16) = (v4u){z0, z0, z0, z0};
          }
      }
    }
}
__device__ __forceinline__ void glr_pre(Frame& F, int l, int mode, int widx, int wcount, int NI_W) {
    constexpr int NI = 24 * NCH;
    const int lo = mode ? NI_W : 0, hi = mode ? NI : NI_W;
    for (int it = lo + widx; it < hi; it += wcount) { const int c = it / 24, u = it % 24;
        if (u < 16) glr_pre_item(F, l, 0, u >> 2, u & 3, c); else glr_pre_item(F, l, 1, (u - 16) >> 1, (u - 16) & 1, c); }
    __syncthreads();
}

__device__ __forceinline__ bf16x8 acc2frag(const f32x16& S, int half) {
    union { unsigned u[4]; bf16x8 v; } x;
    x.u[0] = cvtpk(S[8 * half + 0], S[8 * half + 1]); x.u[1] = cvtpk(S[8 * half + 2], S[8 * half + 3]); x.u[2] = cvtpk(S[8 * half + 4], S[8 * half + 5]); x.u[3] = cvtpk(S[8 * half + 6], S[8 * half + 7]);
    return x.v;
}
#ifndef SCAN_WAIT
#define SCAN_WAIT 0x4F70
#define SCAN_WAIT_RW 0x4F78
#endif
template <bool RW>
__device__ __forceinline__ void scan_pipe(Frame& F, const unsigned char* ub, size_t ubs, const unsigned char* uai, const unsigned char* vt, size_t vts, bf16* obuf, int ldo, float* sout, int st_k, int st_v) {
    LAS float* dl = (LAS float*)(F.lds + RING_OFF + F.wave * 16384);
    int lane = F.lane, r = lane & 31, h2 = lane >> 5;
    f32x16 S0, S1;
#pragma unroll
    for (int e = 0; e < 16; ++e) { S0[e] = 0.f; S1[e] = 0.f; }
    bf16x8 qA[4], aA[4], iA[2], vA[2], kA[2][2], qB[4], aB[4], iB[2], vB[2], kB[2][2], bt[2][2]; float dA, dB;
#define SCAN_LOAD1(c_, Q, A_, I_, V_, K_, DD, BT_) do { const int cc_ = (c_) < NCH ? (c_) : NCH - 1; const unsigned char* u_ = ub + (size_t)cc_ * ubs; const unsigned char* v_ = vt + (size_t)cc_ * vts; \
        _Pragma("unroll") for (int s = 0; s < 4; ++s) { Q[s] = *(const bf16x8*)(u_ + UB_QT + (s * 64 + lane) * 16); if (RW) A_[s] = *(const bf16x8*)(u_ + UB_AT + (s * 64 + lane) * 16); } \
        if (!RW) { _Pragma("unroll") for (int m = 0; m < 2; ++m) _Pragma("unroll") for (int s = 0; s < 2; ++s) K_[m][s] = *(const bf16x8*)(u_ + UB_KT + ((m * 2 + s) * 64 + lane) * 16); } \
        _Pragma("unroll") for (int s = 0; s < 2; ++s) { V_[s] = *(const bf16x8*)(v_ + (s * 64 + lane) * 16); if (uai) I_[s] = *(const bf16x8*)(uai + (size_t)cc_ * ubs + UB_AI + (s * 64 + lane) * 16); } \
        DD = *(const float*)(u_ + UB_DT + lane * 4); } while (0)
#define SCAN_LOADBT(c_) do { const int cb_ = (c_) < NCH ? (c_) : NCH - 1; const unsigned char* u_ = ub + (size_t)cb_ * ubs; \
        _Pragma("unroll") for (int m = 0; m < 2; ++m) _Pragma("unroll") for (int s = 0; s < 2; ++s) { kA[m][s] = *(const bf16x8*)(u_ + UB_KT + ((m * 2 + s) * 64 + lane) * 16); bt[m][s] = *(const bf16x8*)(u_ + UB_BT + ((m * 2 + s) * 64 + lane) * 16); } } while (0)
#define SCAN_BODY(c_, Q, A_, I_, V_, K_, DD, PRED_) do { \
        dl[lane] = DD; \
        const bf16x8 sb0 = acc2frag(S0, 0), sb1 = acc2frag(S0, 1), sb2 = acc2frag(S1, 0), sb3 = acc2frag(S1, 1); \
        bf16x8 ub0, ub1; \
        if (RW) { f32x16 Ut; _Pragma("unroll") for (int e = 0; e < 16; ++e) Ut[e] = 0.f; \
            Ut = MF32(A_[0], sb0, Ut); Ut = MF32(A_[1], sb1, Ut); Ut = MF32(A_[2], sb2, Ut); Ut = MF32(A_[3], sb3, Ut); \
            _Pragma("unroll") for (int e = 0; e < 16; ++e) Ut[e] = -Ut[e]; \
            ub0 = acc2frag(Ut, 0); ub1 = acc2frag(Ut, 1); } \
        f32x16 O; \
        _Pragma("unroll") for (int e = 0; e < 16; ++e) O[e] = 0.f; \
        O = MF32(Q[0], sb0, O); O = MF32(Q[1], sb1, O); O = MF32(Q[2], sb2, O); O = MF32(Q[3], sb3, O); \
        if (uai) { O = MF32(I_[0], V_[0], O); O = MF32(I_[1], V_[1], O); } \
        _Pragma("unroll") for (int e = 0; e < 16; ++e) { const int t = 32 * (c_) + (e & 3) + 8 * (e >> 2) + 4 * h2; if (!(PRED_) || t < TP) obuf[(size_t)t * ldo + r] = (bf16)pg8::cvt_pk_bf16(O[e], 0.f); }   \
        _Pragma("unroll") for (int g = 0; g < 4; ++g) { const f32x4 d0 = *(const LAS f32x4*)(dl + 8 * g + 4 * h2), d1 = *(const LAS f32x4*)(dl + 32 + 8 * g + 4 * h2); \
            _Pragma("unroll") for (int j = 0; j < 4; ++j) { S0[4 * g + j] *= d0[j]; S1[4 * g + j] *= d1[j]; } } \
        S0 = MF32(K_[0][0], V_[0], S0); S0 = MF32(K_[0][1], V_[1], S0); S1 = MF32(K_[1][0], V_[0], S1); S1 = MF32(K_[1][1], V_[1], S1); \
        if (RW) { \
            S0 = MF32(bt[0][0], ub0, S0); S0 = MF32(bt[0][1], ub1, S0); S1 = MF32(bt[1][0], ub0, S1); S1 = MF32(bt[1][1], ub1, S1); } \
        asm volatile("" ::: "memory"); } while (0)
    static_assert(NCH % 2 == 1 && 32 * (NCH - 1) <= TP, "chunk 0 and the last pair are peeled; only the last chunk is partial");
    SCAN_LOAD1(0, qA, aA, iA, vA, kA, dA, 0);
    __builtin_amdgcn_s_waitcnt(0x0F70);
    if (RW) SCAN_LOADBT(0);
    SCAN_LOAD1(1, qB, aB, iB, vB, kB, dB, 0);
    SCAN_BODY(0, qA, aA, iA, vA, kA, dA, 0);
    for (int c = 1; c + 2 < NCH; c += 2) {
        __builtin_amdgcn_s_waitcnt(SCAN_WAIT);
        if (RW) SCAN_LOADBT(c);
        SCAN_LOAD1(c + 1, qA, aA, iA, vA, kA, dA, 0);
        if (RW) SCAN_BODY(c, qB, aB, iB, vB, kA, dB, 0); else SCAN_BODY(c, qB, aB, iB, vB, kB, dB, 0);
        __builtin_amdgcn_s_waitcnt(SCAN_WAIT);
        if (RW) SCAN_LOADBT(c + 1);
        SCAN_LOAD1(c + 2, qB, aB, iB, vB, kB, dB, 0);
        SCAN_BODY(c + 1, qA, aA, iA, vA, kA, dA, 0);
    }
    asm volatile("" : "+v"(lane)); r = lane & 31; h2 = lane >> 5;
    __builtin_amdgcn_s_waitcnt(SCAN_WAIT);
    if (RW) SCAN_LOADBT(NCH - 2);
    SCAN_LOAD1(NCH - 1, qA, aA, iA, vA, kA, dA, 0);
    if (RW) SCAN_BODY(NCH - 2, qB, aB, iB, vB, kA, dB, 0); else SCAN_BODY(NCH - 2, qB, aB, iB, vB, kB, dB, 0);
    if (RW) SCAN_LOADBT(NCH - 1);
    SCAN_BODY(NCH - 1, qA, aA, iA, vA, kA, dA, 1);
#undef SCAN_LOAD1
#undef SCAN_BODY
#undef SCAN_LOADBT
    if (RW) {
#pragma unroll
        for (int g = 0; g < 4; ++g) { *(f32x4*)(sout + (size_t)r * st_v + 8 * g + 4 * h2) = (f32x4){S0[4 * g], S0[4 * g + 1], S0[4 * g + 2], S0[4 * g + 3]}; *(f32x4*)(sout + (size_t)r * st_v + 32 + 8 * g + 4 * h2) = (f32x4){S1[4 * g], S1[4 * g + 1], S1[4 * g + 2], S1[4 * g + 3]}; }
    } else {
#pragma unroll
        for (int e = 0; e < 16; ++e) { const int k = (e & 3) + 8 * (e >> 2) + 4 * h2; sout[(size_t)k * st_k + (size_t)r * st_v] = S0[e]; sout[(size_t)(k + 32) * st_k + (size_t)r * st_v] = S1[e]; }
    }
}
__device__ __forceinline__ void scan_glr_item(Frame& F, int l, int it) {
    if (it < 128) { const int sl = it & 3, kh = (it >> 2) & 1, h = (it >> 3) & 3, b = it >> 5;
        const int unit = (b * 4 + h) * 2 + kh;
        const unsigned char* ub = F.ws + WS_GU + (size_t)unit * NCH * UBG;
        const unsigned char* uai = kh == 0 ? ub : nullptr;
        const unsigned char* vt = F.ws + WS_GV + ((((size_t)b * 8 + h) * NCH) * 4 + sl) * 2048;
        bf16* ob = (kh == 0 ? WSP(bf16, WS_OH) : WSP(bf16, WS_OH1)) + (size_t)(b * TP) * 512 + h * 128 + sl * 32;
        float* so = F.out + O_HGP + (((size_t)l * NB + b) * 4 + h) * 16384 + (size_t)(64 * kh) * 128 + sl * 32;
        scan_pipe<false>(F, ub, UBG, uai, vt, 4 * 2048, ob, 512, so, 128, 1);
    } else { const int r = it - 128, sl = r & 3, h = (r >> 2) & 3, b = r >> 4;
        const int unit = NU_H + b * 4 + h;
        const unsigned char* ub = F.ws + WS_GU + (size_t)unit * NCH * UBG;
        const unsigned char* vt = F.ws + WS_GV + ((((size_t)b * 8 + 4 + h) * NCH) * 4 + sl) * 2048;
        bf16* ob = WSP(bf16, WS_OG) + (size_t)(b * TP) * 512 + h * 128 + sl * 32;
        float* so = F.out + O_GLP + (((size_t)l * NB + b) * 4 + h) * 8192 + sl * 32;
        scan_pipe<false>(F, ub, UBG, ub, vt, 4 * 2048, ob, 512, so, 128, 1);
    }
}
constexpr size_t RW_LDS_IMG = 0;
constexpr size_t RW_LDS_LOX = 20480;
constexpr size_t RW_LDS_LW = RW_LDS_LOX + 32 * 264 * 2;
constexpr size_t RW_LDS_AA = RW_LDS_LW + 8192;
constexpr size_t RW_LDS_QS = RW_LDS_AA + 8192;
constexpr size_t RW_LDS_GB = RW_LDS_QS + 2048;
constexpr size_t RW_LDS_F32 = RW_LDS_GB + 4 * 32 * 72 * 2;
constexpr size_t RW_LDS_VS = RW_LDS_F32 + 4 * 8192;
constexpr size_t RW_LDS_MM = RW_LDS_LOX;
constexpr size_t RW_LDS_TT = RW_LDS_MM + 4 * 32 * 33 * 4;
constexpr size_t RW_LDS_M1 = RW_LDS_TT + 32 * 33 * 4;
constexpr size_t RW_LDS_AH = RW_LDS_M1 + 32 * 33 * 4;
static_assert(RW_LDS_AH + 8192 <= RW_LDS_GB, "rwkv pre LDS overlay");
constexpr size_t RW_LDS_END = RW_LDS_VS + 8192;
static_assert(RW_LDS_END <= RING_BYTES, "rwkv pre LDS");
__device__ __forceinline__ bf16x8 ldsfrag(const LAS float* p, int cs) {
    union { unsigned u[4]; bf16x8 v; } x;
    x.u[0] = cvtpk(p[0], p[cs]); x.u[1] = cvtpk(p[2 * cs], p[3 * cs]); x.u[2] = cvtpk(p[4 * cs], p[5 * cs]); x.u[3] = cvtpk(p[6 * cs], p[7 * cs]);
    return x.v;
}
__device__ __forceinline__ int lds_s(int x) { asm volatile("" : "+s"(x)); return x; }
__device__ __forceinline__ int lds_v(int x) { asm volatile("" : "+v"(x)); return x; }
__device__ __forceinline__ float fsig(float x) { return __builtin_amdgcn_rcpf(1.f + __expf(-x)); }
__device__ __forceinline__ float ftanh(float x) { return 1.f - 2.f * __builtin_amdgcn_rcpf(1.f + __expf(2.f * x)); }
__device__ __forceinline__ void rwkv_pre_item(Frame& F, int l, int b, int h, int c) {
    LAS unsigned char* L = F.lds + RING_OFF;
    LAS unsigned short* IMG = (LAS unsigned short*)(L + RW_LDS_IMG);
    LAS unsigned short* LOX = (LAS unsigned short*)(L + RW_LDS_LOX);
    LAS float* LW = (LAS float*)(L + RW_LDS_LW); LAS float* AA = (LAS float*)(L + RW_LDS_AA); LAS float* QS = (LAS float*)(L + RW_LDS_QS);
    LAS unsigned short* GB = (LAS unsigned short*)(L + RW_LDS_GB);
    LAS float* AF = (LAS float*)(L + RW_LDS_F32); LAS float* RF = AF + 2048; LAS float* BPF = RF + 2048; LAS float* KPF = BPF + 2048;
    LAS float* VS = (LAS float*)(L + RW_LDS_VS); LAS float* MM = (LAS float*)(L + RW_LDS_MM); LAS float* TT = (LAS float*)(L + RW_LDS_TT); LAS float* M1 = (LAS float*)(L + RW_LDS_M1); LAS float* AH = (LAS float*)(L + RW_LDS_AH);
    const bf16* P = WSP(bf16, WS_P); const float* mu = GIN(13) + (size_t)l * RC;
    const int t0 = 32 * c; const size_t rowb = (size_t)b * TP;
    unsigned short cR[4], cK[4], cV[4], pR[4], pK[4], pV[4];
    { const int k_ = F.lane, tq_ = F.wave, col_ = h * 64 + k_;
#pragma unroll
      for (int i = 0; i < 4; ++i) { const int t = t0 + 4 * tq_ + i; const bf16* p = P + (rowb + (t < TP ? t : 0)) * INP;
          cR[i] = p[col_]; cK[i] = p[512 + col_]; cV[i] = p[1024 + col_];
          pR[i] = t > 0 ? p[col_ - INP] : (unsigned short)0; pK[i] = t > 0 ? p[512 + col_ - INP] : (unsigned short)0; pV[i] = t > 0 ? p[1024 + col_ - INP] : (unsigned short)0; } }
    __syncthreads();
    for (int idx = F.tid; idx < 32 * 256; idx += NTHR) {
        const int tt = idx >> 8, col = idx & 255, t = t0 + tt; const int pc = 1536 + col;
        float v = 0.f;
        if (t < TP) { const bf16* p = P + (rowb + t) * INP; const float cur = bf2f(p[pc]); const float prev = t > 0 ? bf2f(p[pc - INP]) : 0.f; const float x = cur + (prev - cur) * mu[pc];
            v = col < 64 ? ftanh(x) : (col < 128 ? x : fsig(x)); }
        LOX[tt * 264 + col] = (unsigned short)f2bf(v);
    }
    __syncthreads();
    if (F.wave < 6) {
        const int wv_ = lds_s(F.wave), ln_ = lds_v(F.lane);
        const int qn = wv_ >> 1, nt = wv_ & 1, r = ln_ & 31, h2 = ln_ >> 5;
        const int kw = qn == 2 ? 128 : 64, ko = qn == 0 ? 0 : (qn == 1 ? 64 : 128);
        const bf16* WT = qn == 0 ? WSP(bf16, WS_WUPT) + (size_t)l * 512 * 64 : (qn == 1 ? WSP(bf16, WS_AUPT) + (size_t)l * 512 * 64 : WSP(bf16, WS_GUPT) + (size_t)l * 512 * 128);
        const int col = h * 64 + 32 * nt + r;
        f32x16 acc;
#pragma unroll
        for (int e = 0; e < 16; ++e) acc[e] = 0.f;
        for (int s = 0; s < kw / 16; ++s) {
            const bf16x8 af = *(const LAS bf16x8*)(LOX + r * 264 + ko + 16 * s + 8 * h2);
            const bf16x8 bf = *(const bf16x8*)(WT + (size_t)col * kw + 16 * s + 8 * h2);
            acc = __builtin_amdgcn_mfma_f32_32x32x16_bf16(af, bf, acc, 0, 0, 0);
        }
        const float c0 = qn == 0 ? GIN(14)[(size_t)l * 512 + col] : (qn == 1 ? GIN(16)[(size_t)l * 512 + col] : 0.f);
        bf16* GBUF = WSP(bf16, WS_RG);
#pragma unroll
        for (int e = 0; e < 16; ++e) { const int tt = (e & 3) + 8 * (e >> 2) + 4 * h2; const float x = acc[e] + c0;
            if (qn == 0) LW[tt * 64 + 32 * nt + r] = -0.606531f * fsig(x);
            else if (qn == 1) AA[tt * 64 + 32 * nt + r] = fsig(x);
            else if (t0 + tt < TP) GBUF[(rowb + t0 + tt) * 512 + col] = (bf16)f2bf(x); }
    }
    __syncthreads();
    const int k = lds_v(F.lane), tq = lds_s(F.wave), col = h * 64 + k;
    float lwv[4], cin[4], rr[4], km[4], kkv[4], kav[4], vv[4];
    { const float kkw = GIN(19)[(size_t)l * 512 + col], kaw = GIN(20)[(size_t)l * 512 + col], rkw = GIN(21)[(size_t)l * 512 + col];
      const float mur = mu[col], muk = mu[512 + col], muv = mu[1024 + col];
      float* BV = WSP(float, WS_RBV);
      float run = 0.f;
#pragma unroll
      for (int i = 0; i < 4; ++i) {
          const int tt = 4 * tq + i, t = t0 + tt; const bool ok = t < TP;
          const float cr = bf2f(cR[i]), ck = bf2f(cK[i]), cv = bf2f(cV[i]);
          const float pr = bf2f(pR[i]), pk = bf2f(pK[i]), pv = bf2f(pV[i]);
          float r_ = cr + (pr - cr) * mur, k_ = ck + (pk - ck) * muk, v_ = cv + (pv - cv) * muv;
          const float a_ = AA[tt * 64 + k]; float lw_ = LW[tt * 64 + k];
          float kk_ = k_ * kkw;
          const float nrm = fmaxf(sqrtf(wave_sum(kk_ * kk_)), 1e-12f);
          kk_ = kk_ / nrm;
          float kmod = k_ * (1.f + (a_ - 1.f) * kaw);
          if (!ok) { r_ = 0.f; kmod = 0.f; v_ = 0.f; kk_ = 0.f; lw_ = 0.f; }
          const float bonus = wave_sum(r_ * kmod * rkw);
          if (ok) BV[(rowb + t) * 512 + col] = bonus * v_;
          run += lw_; lwv[i] = lw_; cin[i] = run; rr[i] = r_; km[i] = kmod; kkv[i] = kk_; kav[i] = kk_ * a_; vv[i] = v_;
      }
      QS[tq * 64 + k] = run;
    }
    __syncthreads();
    float c31 = 0.f, pre = 0.f;
#pragma unroll
    for (int q2 = 0; q2 < 8; ++q2) { const float x = QS[q2 * 64 + k]; c31 += x; if (q2 < tq) pre += x; }
#pragma unroll
    for (int i = 0; i < 4; ++i) {
        const int tt = 4 * tq + i; const float ci = cin[i] + pre, ce = ci - lwv[i];
        const float en = __expf(-ci), ep = __expf(c31 - ci);
        const float a_i = __expf(ce) * kkv[i], b_i = kav[i] * en, kt_i = km[i] * en, rt_i = rr[i] * __expf(ci), bp_i = kav[i] * ep, kp_i = km[i] * ep;
        GB[(0 * 32 + tt) * 72 + k] = (unsigned short)f2bf(b_i); GB[(1 * 32 + tt) * 72 + k] = (unsigned short)f2bf(kt_i);
        GB[(2 * 32 + tt) * 72 + k] = (unsigned short)f2bf(a_i); GB[(3 * 32 + tt) * 72 + k] = (unsigned short)f2bf(rt_i);
        AF[tt * 64 + k] = a_i; RF[tt * 64 + k] = rt_i; BPF[tt * 64 + k] = bp_i; KPF[tt * 64 + k] = kp_i; VS[tt * 64 + k] = vv[i];
    }
    if (tq == 0) ((LAS float*)(IMG + UB_DT / 2))[k] = expf(c31);
    __syncthreads();
    if (F.tid < 256) { const int v = F.tid & 63, q = F.tid >> 6; unsigned w[4];
#pragma unroll
        for (int i = 0; i < 8; i += 2) w[i >> 1] = pk2(VS[(8 * q + i) * 64 + v], VS[(8 * q + i + 1) * 64 + v]);
        unsigned char* vt = F.ws + WS_RV + ((((size_t)b * 8 + h) * NCH + c) * 2 + (v >> 5)) * 2048;
        *(v4u*)(vt + (((q >> 1) * 2 + (q & 1)) * 32 + (v & 31)) * 16) = (v4u){w[0], w[1], w[2], w[3]}; }
    if (F.wave < 4) {
        const int wv_ = lds_s(F.wave), ln_ = lds_v(F.lane);
        const int rs = wv_ >> 1, cs = wv_ & 1, r = ln_ & 31, h2 = ln_ >> 5;
        f32x16 acc;
#pragma unroll
        for (int e = 0; e < 16; ++e) acc[e] = 0.f;
#pragma unroll
        for (int s = 0; s < 4; ++s) {
            const bf16x8 af = *(const LAS bf16x8*)(GB + (rs * 32 + r) * 72 + 16 * s + 8 * h2);
            const bf16x8 bf = *(const LAS bf16x8*)(GB + ((2 + cs) * 32 + r) * 72 + 16 * s + 8 * h2);
            acc = __builtin_amdgcn_mfma_f32_32x32x16_bf16(af, bf, acc, 0, 0, 0);
        }
#pragma unroll
        for (int e = 0; e < 16; ++e) { const int j = (e & 3) + 8 * (e >> 2) + 4 * h2, i = r; const bool keep = cs ? (j <= i) : (j < i); MM[(wv_ * 32 + j) * 33 + i] = keep ? acc[e] : 0.f; }
    }
    __syncthreads();
    const LAS float* Mba = MM; const LAS float* Mbr = MM + 32 * 33; const LAS float* Mka = MM + 2 * 32 * 33; const LAS float* Mkr = MM + 3 * 32 * 33;
    if (F.wave == 0 && F.lane < 32) {
        const int ln_ = lds_v(F.lane);
        const int i = ln_ & 15, base = ln_ & 16; float t[16];
#pragma unroll
        for (int j = 15; j >= 0; --j) { float acc = (j == i) ? 1.f : 0.f;
#pragma unroll
            for (int m = j + 1; m < 16; ++m) acc -= Mba[(base + j) * 33 + base + m] * t[m];
            t[j] = acc; }
#pragma unroll
        for (int j = 0; j < 16; ++j) { TT[(base + j) * 33 + base + i] = t[j]; if (base == 0) TT[(16 + j) * 33 + i] = 0.f; }
    }
    __syncthreads();
    if (F.tid < 256) { const int j = F.tid >> 4, i = F.tid & 15; float sacc = 0.f;
#pragma unroll
        for (int m = 0; m < 16; ++m) sacc += Mba[j * 33 + 16 + m] * TT[(16 + m) * 33 + 16 + i];
        M1[j * 16 + i] = sacc; }
    __syncthreads();
    if (F.tid < 256) { const int j = F.tid >> 4, i = F.tid & 15; float sacc = 0.f;
#pragma unroll
        for (int m = 0; m < 16; ++m) sacc -= TT[j * 33 + m] * M1[m * 16 + i];
        TT[j * 33 + 16 + i] = sacc; }
    __syncthreads();
    { const int ln_ = lds_v(F.lane), wv_ = lds_s(F.wave); const int r = ln_ & 31, h2 = ln_ >> 5;
      if (wv_ == 0) { f32x16 acc;
#pragma unroll
          for (int e = 0; e < 16; ++e) acc[e] = 0.f;
#pragma unroll
          for (int s2 = 0; s2 < 2; ++s2) acc = __builtin_amdgcn_mfma_f32_32x32x16_bf16(ldsfrag(Mka + r * 33 + 16 * s2 + 8 * h2, 1), ldsfrag(TT + (16 * s2 + 8 * h2) * 33 + r, 33), acc, 0, 0, 0);
#pragma unroll
          for (int e = 0; e < 16; ++e) M1[((e & 3) + 8 * (e >> 2) + 4 * h2) * 33 + r] = acc[e];
      } else if (wv_ < 3) { const int nt = wv_ - 1, kk2 = 32 * nt + r; f32x16 acc;
#pragma unroll
          for (int e = 0; e < 16; ++e) acc[e] = 0.f;
#pragma unroll
          for (int s2 = 0; s2 < 2; ++s2) acc = __builtin_amdgcn_mfma_f32_32x32x16_bf16(ldsfrag(TT + (16 * s2 + 8 * h2) * 33 + r, 33), ldsfrag(AF + (16 * s2 + 8 * h2) * 64 + kk2, 64), acc, 0, 0, 0);
          const int s = kk2 >> 4, hp = (kk2 >> 2) & 1, jp = ((kk2 >> 3) & 1) * 4 + (kk2 & 3);
#pragma unroll
          for (int e = 0; e < 16; ++e) { const int i = (e & 3) + 8 * (e >> 2) + 4 * h2; AH[i * 64 + kk2] = acc[e]; IMG[(UB_AT + ((s * 2 + hp) * 32 + i) * 16 + jp * 2) / 2] = (unsigned short)f2bf(acc[e]); }
      }
    }
    __syncthreads();
    { const int ln_ = lds_v(F.lane), wv_ = lds_s(F.wave); const int r = ln_ & 31, h2 = ln_ >> 5;
      if (wv_ == 0) { f32x16 acc;
#pragma unroll
          for (int e = 0; e < 16; ++e) acc[e] = 0.f;
#pragma unroll
          for (int s2 = 0; s2 < 2; ++s2) acc = __builtin_amdgcn_mfma_f32_32x32x16_bf16(ldsfrag(M1 + r * 33 + 16 * s2 + 8 * h2, 1), ldsfrag(Mbr + (16 * s2 + 8 * h2) * 33 + r, 33), acc, 0, 0, 0);
#pragma unroll
          for (int e = 0; e < 16; ++e) { const int j = (e & 3) + 8 * (e >> 2) + 4 * h2, i = r; const float v = Mkr[j * 33 + i] - acc[e];
              IMG[(UB_AI + (((j >> 4) * 2 + ((j >> 3) & 1)) * 32 + i) * 16 + (j & 7) * 2) / 2] = (unsigned short)f2bf(v); }
      } else if (wv_ < 3) { const int nt = wv_ - 1, kk2 = 32 * nt + r; f32x16 acc;
#pragma unroll
          for (int e = 0; e < 16; ++e) acc[e] = 0.f;
#pragma unroll
          for (int s2 = 0; s2 < 2; ++s2) acc = __builtin_amdgcn_mfma_f32_32x32x16_bf16(ldsfrag(Mbr + (16 * s2 + 8 * h2) * 33 + r, 33), ldsfrag(AH + (16 * s2 + 8 * h2) * 64 + kk2, 64), acc, 0, 0, 0);
          const int s = kk2 >> 4, hp = (kk2 >> 2) & 1, jp = ((kk2 >> 3) & 1) * 4 + (kk2 & 3);
#pragma unroll
          for (int e = 0; e < 16; ++e) { const int i = (e & 3) + 8 * (e >> 2) + 4 * h2; IMG[(UB_QT + ((s * 2 + hp) * 32 + i) * 16 + jp * 2) / 2] = (unsigned short)f2bf(RF[i * 64 + kk2] - acc[e]); }
      } else if (wv_ < 5) { const int nt = wv_ - 3, kk2 = 32 * nt + r; f32x16 acc;
#pragma unroll
          for (int e = 0; e < 16; ++e) acc[e] = 0.f;
#pragma unroll
          for (int s2 = 0; s2 < 2; ++s2) acc = __builtin_amdgcn_mfma_f32_32x32x16_bf16(ldsfrag(M1 + r * 33 + 16 * s2 + 8 * h2, 1), ldsfrag(BPF + (16 * s2 + 8 * h2) * 64 + kk2, 64), acc, 0, 0, 0);
          const int m = kk2 >> 5, rr2 = kk2 & 31;
#pragma unroll
          for (int e = 0; e < 16; ++e) { const int j = (e & 3) + 8 * (e >> 2) + 4 * h2; IMG[(UB_KT + (((m * 2 + (j >> 4)) * 2 + ((j >> 3) & 1)) * 32 + rr2) * 16 + (j & 7) * 2) / 2] = (unsigned short)f2bf(KPF[j * 64 + kk2] - acc[e]); }
      } else { for (int o = lds_v(F.tid) - 320; o < 2048; o += 192) { const int i = o >> 6, kk2 = o & 63, m = kk2 >> 5, rr2 = kk2 & 31, w = i & 15, ep = ((w >> 3) & 1) * 4 + (w & 3), hq = (w >> 2) & 1;
              IMG[(UB_BT + (((m * 2 + (i >> 4)) * 2 + hq) * 32 + rr2) * 16 + ep * 2) / 2] = (unsigned short)f2bf(BPF[i * 64 + kk2]); } }
    }
    __syncthreads();
    { unsigned char* ub = F.ws + WS_RU + (((size_t)b * 8 + h) * NCH + c) * UBR;
      for (int o = F.tid; o < UBR / 16; o += NTHR) *(v4u*)(ub + o * 16) = *(const LAS v4u*)(L + RW_LDS_IMG + o * 16); }
}
__device__ __forceinline__ void rwkv_pre(Frame& F, int l) {
    for (int it = blockIdx.x; it < NB * 8 * NCH; it += F.G) { const int c = it % NCH, bh = it / NCH; rwkv_pre_item(F, l, bh >> 3, bh & 7, c); }
    __syncthreads();
}
__device__ __forceinline__ void scan_rwkv_chunked(Frame& F, int l, int b, int h, int sl) {
    const unsigned char* ub = F.ws + WS_RU + (((size_t)b * 8 + h) * NCH) * UBR;
    const unsigned char* vt = F.ws + WS_RV + ((((size_t)b * 8 + h) * NCH) * 2 + sl) * 2048;
    bf16* obuf = WSP(bf16, WS_RY) + (size_t)(b * TP) * 512 + h * 64 + sl * 32;
    float* so = F.out + O_RWP + ((((size_t)l * NB + b) * 8 + h) * 64 + sl * 32) * 64;
    scan_pipe<true>(F, ub, UBR, ub, vt, 2 * 2048, obuf, 512, so, 1, 64);
}
__device__ __forceinline__ void unpack8(const v4u a, float (&o)[8]);
__device__ __forceinline__ bf16x8 pack8f(const float (&v)[8]) { union { unsigned u[4]; bf16x8 x; } q; q.u[0] = cvtpk(v[0], v[1]); q.u[1] = cvtpk(v[2], v[3]); q.u[2] = cvtpk(v[4], v[5]); q.u[3] = cvtpk(v[6], v[7]); return q.x; }
__device__ __forceinline__ bf16x8 u4frag(const unsigned (&u)[4]) { union { unsigned w[4]; bf16x8 x; } q; q.w[0] = u[0]; q.w[1] = u[1]; q.w[2] = u[2]; q.w[3] = u[3]; return q.x; }
__device__ __forceinline__ f32x16 negt(const f32x16& a) { f32x16 o;
#pragma unroll
    for (int e = 0; e < 16; ++e) o[e] = -a[e];
    return o; }
__device__ __forceinline__ float half_sum(float v) { v += __shfl_xor(v, 1); v += __shfl_xor(v, 2); v += __shfl_xor(v, 4); v += __shfl_xor(v, 8); v += __shfl_xor(v, 16); return v; }
template <int STAGE, int WMASK = 31>
__device__ __forceinline__ void rwkv_pre_wave(Frame& F, int l, int b, int h, int c) {
    LAS unsigned char* L = F.lds + RING_OFF + F.wave * 16384;
    const int lane = F.lane, r = lane & 31, h2 = lane >> 5;
    const bf16* P = WSP(bf16, WS_P); const float* mu = GIN(13) + (size_t)l * RC;
    const int t0 = 32 * c; const size_t rowb = (size_t)b * TP;
    unsigned char* ub = F.ws + WS_RU + (((size_t)b * 8 + h) * NCH + c) * UBR;
#define TAU(e) (((e) & 3) + 8 * ((e) >> 2) + 4 * h2)
    static_assert(TP - 32 * (NCH - 1) == 16, "the last chunk holds 16 tokens");
    const bool lastc = (c == NCH - 1);
#define OKE(e) (!lastc || (e) < 8)
    f32x16 lw[2], av[2];
    { f32x16 aw[2], aa[2], ag[2];
#pragma unroll
      for (int nt = 0; nt < 2; ++nt)
#pragma unroll
          for (int e = 0; e < 16; ++e) { aw[nt][e] = 0.f; aa[nt][e] = 0.f; ag[nt][e] = 0.f; }
      const int tok = t0 + r; const bool tv = !lastc || r < 16; const bf16* prow = P + (rowb + (tv ? tok : 0)) * INP;
      const bf16* WU = WSP(bf16, WS_WUPT) + ((size_t)l * 512 + h * 64 + r) * 64; const bf16* AU = WSP(bf16, WS_AUPT) + ((size_t)l * 512 + h * 64 + r) * 64; const bf16* GU = WSP(bf16, WS_GUPT) + ((size_t)l * 512 + h * 64 + r) * 128;
#pragma unroll
      for (int s = 0; s < 16; ++s) {
          const int pc = 1536 + 16 * s + 8 * h2;
          float x[8]; { float cu[8], pv[8]; unpack8(*(const v4u*)(prow + pc), cu);
              if (tok > 0) unpack8(*(const v4u*)(prow + pc - INP), pv); else {
#pragma unroll
                  for (int j = 0; j < 8; ++j) pv[j] = 0.f; }
              const f32x4 m0 = *(const f32x4*)(mu + pc), m1 = *(const f32x4*)(mu + pc + 4); const float mm[8] = {m0.x, m0.y, m0.z, m0.w, m1.x, m1.y, m1.z, m1.w};
#pragma unroll
              for (int j = 0; j < 8; ++j) { const float y = cu[j] + (pv[j] - cu[j]) * mm[j]; x[j] = tv ? (s < 4 ? ftanh(y) : (s < 8 ? y : fsig(y))) : 0.f; } }
          const bf16x8 af = pack8f(x);
#pragma unroll
          for (int nt = 0; nt < 2; ++nt) {
              if (s < 4) aw[nt] = MF32(af, *(const bf16x8*)(WU + (size_t)(32 * nt) * 64 + 16 * s + 8 * h2), aw[nt]);
              else if (s < 8) aa[nt] = MF32(af, *(const bf16x8*)(AU + (size_t)(32 * nt) * 64 + 16 * (s - 4) + 8 * h2), aa[nt]);
              else ag[nt] = MF32(af, *(const bf16x8*)(GU + (size_t)(32 * nt) * 128 + 16 * (s - 8) + 8 * h2), ag[nt]);
          }
          if ((s & 3) == 3) __builtin_amdgcn_sched_barrier(0);
      }
      bf16* gb = WSP(bf16, WS_RG) + (rowb + t0 + 4 * h2) * 512 + h * 64 + r;
#pragma unroll
      for (int nt = 0; nt < 2; ++nt) { const int col = h * 64 + 32 * nt + r; const float w0c = GIN(14)[(size_t)l * 512 + col], a0c = GIN(16)[(size_t)l * 512 + col];
#pragma unroll
          for (int e = 0; e < 16; ++e) { lw[nt][e] = -0.606531f * fsig(aw[nt][e] + w0c); av[nt][e] = fsig(aa[nt][e] + a0c);
              if (OKE(e)) gb[((e & 3) + 8 * (e >> 2)) * 512 + 32 * nt] = (bf16)f2bf(ag[nt][e]); } }
    }
    __builtin_amdgcn_sched_barrier(0);
    float pre[2][4], c31[2];
#pragma unroll
    for (int nt = 0; nt < 2; ++nt) { float qs[4], pq[4];
#pragma unroll
        for (int g = 0; g < 4; ++g) { float run = 0.f;
#pragma unroll
            for (int i = 0; i < 4; ++i) { if (!OKE(4 * g + i)) lw[nt][4 * g + i] = 0.f; run += lw[nt][4 * g + i]; }
            qs[g] = run; pq[g] = __shfl_xor(run, 32); }
        float run = 0.f;
#pragma unroll
        for (int g = 0; g < 4; ++g) { pre[nt][g] = run + (h2 ? pq[g] : 0.f); run += qs[g] + pq[g]; }
        c31[nt] = run; }
    LAS unsigned short* PS = (LAS unsigned short*)L;
    asm volatile("" ::: "memory");
    for (int idx = lane; idx < 33 * 24; idx += 64) { const int i = idx / 24, p = idx % 24, tk = t0 - 1 + i;
        v4u v = {0u, 0u, 0u, 0u}; if (tk >= 0 && tk < TP) v = *(const v4u*)(P + (rowb + tk) * INP + (p >> 3) * 512 + h * 64 + (p & 7) * 8);
        *(LAS v4u*)(PS + i * 200 + (p >> 3) * 64 + (p & 7) * 8) = v; }
    LDS_WAIT(); asm volatile("" ::: "memory");
    float mur[2], muk[2], muv[2], kkw[2], kaw[2], rkw[2];
#pragma unroll
    for (int nt = 0; nt < 2; ++nt) { const int col = h * 64 + 32 * nt + r; mur[nt] = mu[col]; muk[nt] = mu[512 + col]; muv[nt] = mu[1024 + col];
        kkw[nt] = GIN(19)[(size_t)l * 512 + col]; kaw[nt] = GIN(20)[(size_t)l * 512 + col]; rkw[nt] = GIN(21)[(size_t)l * 512 + col]; }
    float inv[16];
    { bf16* bvp = WSP(bf16, WS_RBV) + (rowb + t0 + 4 * h2) * 512 + h * 64 + r;
#pragma unroll
      for (int e = 0; e < 16; ++e) { float n2 = 0.f, bo = 0.f, v2[2];
#pragma unroll
          for (int nt = 0; nt < 2; ++nt) { const LAS unsigned short* q = PS + (1 + TAU(e)) * 200 + 32 * nt + r;
              const float cr = bf2f(q[0]), ck = bf2f(q[64]), cv = bf2f(q[128]), pr = bf2f(q[-200]), pk = bf2f(q[-200 + 64]), pv = bf2f(q[-200 + 128]);
              const float r_ = cr + (pr - cr) * mur[nt], k_ = ck + (pk - ck) * muk[nt], kr = k_ * kkw[nt], kmod = k_ * (1.f + (av[nt][e] - 1.f) * kaw[nt]);
              v2[nt] = cv + (pv - cv) * muv[nt];
              if (OKE(e)) { n2 += kr * kr; bo += r_ * kmod * rkw[nt]; } }
          inv[e] = __builtin_amdgcn_rsqf(fmaxf(half_sum(n2), 1e-24f));        const float bon = half_sum(bo);
          if (OKE(e)) { bvp[((e & 3) + 8 * (e >> 2)) * 512] = (bf16)f2bf(bon * v2[0]); bvp[((e & 3) + 8 * (e >> 2)) * 512 + 32] = (bf16)f2bf(bon * v2[1]); }
          __builtin_amdgcn_sched_barrier(0); } }
    unsigned char* scr = F.ws + WS_RSCR + (size_t)(F.gw & 2047) * 20480 + lane * 16;
#define SCRF(mat, nt, hf) (*(bf16x8*)(scr + (((mat) * 2 + (nt)) * 2 + (hf)) * 1024))
#define BTF(nt, hf) (*(bf16x8*)(ub + UB_BT + (((nt) * 2 + (hf)) * 64 + lane) * 16))
#pragma unroll
    for (int nt = 0; nt < 2; ++nt) {
        unsigned char* vt = F.ws + WS_RV + ((((size_t)b * 8 + h) * NCH + c) * 2 + nt) * 2048;
#pragma unroll
        for (int hf = 0; hf < 2; ++hf) { unsigned au[4], bu[4], ku[4], ru[4], pu[4], qu[4], vu[4];
#pragma unroll
            for (int g2 = 0; g2 < 2; ++g2) { float run = pre[nt][2 * hf + g2];
#pragma unroll
                for (int i2 = 0; i2 < 2; ++i2) { float a2[2], b2[2], k2[2], r2[2], p2[2], q2[2], v2[2];
#pragma unroll
                    for (int i1 = 0; i1 < 2; ++i1) { const int i = 2 * i2 + i1, j = 4 * g2 + i, e = 8 * hf + j; const bool ok = OKE(e);
                        run += lw[nt][e]; const float ci = run;
                        const LAS unsigned short* q = PS + (1 + TAU(e)) * 200 + 32 * nt + r;
                        const float cr = bf2f(q[0]), ck = bf2f(q[64]), cv = bf2f(q[128]), pr = bf2f(q[-200]), pk = bf2f(q[-200 + 64]), pv = bf2f(q[-200 + 128]);
                        float r_ = cr + (pr - cr) * mur[nt], k_ = ck + (pk - ck) * muk[nt], v_ = cv + (pv - cv) * muv[nt];
                        float kkn = k_ * kkw[nt] * inv[e], kmod = k_ * (1.f + (av[nt][e] - 1.f) * kaw[nt]);
                        if (!ok) { r_ = 0.f; kmod = 0.f; v_ = 0.f; kkn = 0.f; }
                        const float ka = kkn * av[nt][e], en = __expf(-ci), e31 = __expf(c31[nt] - ci);
                        a2[i1] = __expf(ci - lw[nt][e]) * kkn; b2[i1] = ka * en; k2[i1] = kmod * en; r2[i1] = r_ * __expf(ci); p2[i1] = ka * e31; q2[i1] = kmod * e31; v2[i1] = v_; }
                    const int w = 2 * g2 + i2;
                    au[w] = cvtpk(a2[0], a2[1]); bu[w] = cvtpk(b2[0], b2[1]); ku[w] = cvtpk(k2[0], k2[1]); ru[w] = cvtpk(r2[0], r2[1]); pu[w] = cvtpk(p2[0], p2[1]); qu[w] = cvtpk(q2[0], q2[1]); vu[w] = cvtpk(v2[0], v2[1]);
                    __builtin_amdgcn_sched_barrier(0); } }
            SCRF(0, nt, hf) = u4frag(au); SCRF(1, nt, hf) = u4frag(bu); SCRF(2, nt, hf) = u4frag(ku); SCRF(3, nt, hf) = u4frag(ru); SCRF(4, nt, hf) = u4frag(qu);
            if (STAGE >= 2 && (WMASK & 1)) *(bf16x8*)(vt + (hf * 64 + lane) * 16) = u4frag(vu);
            BTF(nt, hf) = u4frag(pu);
            __builtin_amdgcn_sched_barrier(0); }
        if (h2 == 0) *(float*)(ub + UB_DT + (32 * nt + r) * 4) = __expf(c31[nt]);
    }
    if (STAGE < 2) return;
    asm volatile("s_waitcnt vmcnt(0)" ::: "memory");
    __builtin_amdgcn_sched_barrier(0);
    bf16x8 I0, I1;
    { float x0[8], x1[8];
#pragma unroll
      for (int j = 0; j < 8; ++j) { const int m = 8 * (j >> 2) + 4 * h2 + (j & 3); x0[j] = (m == r) ? 1.f : 0.f; x1[j] = (16 + m == r) ? 1.f : 0.f; }
      I0 = pack8f(x0); I1 = pack8f(x1); }
    bf16x8 fB[4], fA[4], fK[4], fR[4];
#pragma unroll
#define TLFRAGS(MAT, FO) do { _Pragma("unroll") for (int nt = 0; nt < 2; ++nt) { f32x16 tt_; _Pragma("unroll") for (int e = 0; e < 16; ++e) tt_[e] = 0.f; \
        tt_ = MF32(SCRF(MAT, nt, 0), I0, tt_); tt_ = MF32(SCRF(MAT, nt, 1), I1, tt_); FO[2 * nt] = acc2frag(tt_, 0); FO[2 * nt + 1] = acc2frag(tt_, 1); } __builtin_amdgcn_sched_barrier(0); } while (0)
    TLFRAGS(1, fB); TLFRAGS(0, fA); TLFRAGS(2, fK); TLFRAGS(3, fR);
#undef TLFRAGS
    __builtin_amdgcn_sched_barrier(0);
    f32x16 Mba, Mbr, X1, Mkr;
#pragma unroll
    for (int e = 0; e < 16; ++e) { Mba[e] = 0.f; Mbr[e] = 0.f; X1[e] = 0.f; Mkr[e] = 0.f; }
#pragma unroll
    for (int s = 0; s < 4; ++s) { Mba = MF32(fB[s], fA[s], Mba); Mbr = MF32(fB[s], fR[s], Mbr); X1 = MF32(fA[s], fK[s], X1); Mkr = MF32(fK[s], fR[s], Mkr); }
    LAS float* NL = (LAS float*)L; LAS float* TT = NL + 32 * 33; LAS float* PX = TT + 32 * 33;
    asm volatile("" ::: "memory");
#pragma unroll
    for (int e = 0; e < 16; ++e) { const int tj = TAU(e);
        Mba[e] = tj < r ? Mba[e] : 0.f; Mbr[e] = tj <= r ? Mbr[e] : 0.f; Mkr[e] = tj <= r ? Mkr[e] : 0.f; X1[e] = r < tj ? X1[e] : 0.f;
        NL[tj * 33 + r] = Mba[e]; }
    LDS_WAIT(); asm volatile("" ::: "memory");
    __builtin_amdgcn_sched_barrier(0);
    { const int i = lane & 15, base = lane & 16; float t[16];
#pragma unroll
      for (int j = 15; j >= 0; --j) { float acc = (j == i) ? 1.f : 0.f;
#pragma unroll
          for (int m = j + 1; m < 16; ++m) acc -= NL[(base + j) * 33 + base + m] * t[m];
          t[j] = acc; }
#pragma unroll
      for (int j = 0; j < 16; ++j) { TT[(base + j) * 33 + base + i] = t[j]; if (base == 0) TT[(16 + j) * 33 + i] = 0.f; }
      LDS_WAIT(); asm volatile("" ::: "memory");
#pragma unroll
      for (int q = 0; q < 4; ++q) { const int o = lane * 4 + q, j = o >> 4, i2 = o & 15; float sacc = 0.f;
#pragma unroll
          for (int m = 0; m < 16; ++m) sacc += NL[j * 33 + 16 + m] * TT[(16 + m) * 33 + 16 + i2];
          PX[j * 16 + i2] = sacc; }
      LDS_WAIT(); asm volatile("" ::: "memory");
#pragma unroll
      for (int q = 0; q < 4; ++q) { const int o = lane * 4 + q, j = o >> 4, i2 = o & 15; float sacc = 0.f;
#pragma unroll
          for (int m = 0; m < 16; ++m) sacc -= TT[j * 33 + m] * PX[m * 16 + i2];
          TT[j * 33 + 16 + i2] = sacc; }
      LDS_WAIT(); asm volatile("" ::: "memory");
    }
    bf16x8 tF[2], trF[2];
#pragma unroll
    for (int s = 0; s < 2; ++s) { float x[8], y[8];
#pragma unroll
        for (int j = 0; j < 8; ++j) { const int m = 16 * s + 8 * (j >> 2) + 4 * h2 + (j & 3); x[j] = TT[m * 33 + r]; y[j] = TT[r * 33 + m]; }
        tF[s] = pack8f(x); trF[s] = pack8f(y); }
    LDS_WAIT(); asm volatile("" ::: "memory");
    __builtin_amdgcn_sched_barrier(0);
    f32x16 Y, W, M2 = Mkr;
#pragma unroll
    for (int e = 0; e < 16; ++e) { Y[e] = 0.f; W[e] = 0.f; }
    Y = MF32(tF[0], acc2frag(X1, 0), Y); Y = MF32(tF[1], acc2frag(X1, 1), Y);
    const bf16x8 mb0 = acc2frag(Mbr, 0), mb1 = acc2frag(Mbr, 1);
    W = MF32(trF[0], mb0, W); W = MF32(trF[1], mb1, W);
    __builtin_amdgcn_sched_barrier(0);
    const f32x16 Yn = negt(Y), Wn = negt(W);
    const bf16x8 yn0 = acc2frag(Yn, 0), yn1 = acc2frag(Yn, 1), wn0 = acc2frag(Wn, 0), wn1 = acc2frag(Wn, 1);
    M2 = MF32(yn0, mb0, M2); M2 = MF32(yn1, mb1, M2);
    if (WMASK & 2) { *(bf16x8*)(ub + UB_AI + lane * 16) = acc2frag(M2, 0); *(bf16x8*)(ub + UB_AI + (64 + lane) * 16) = acc2frag(M2, 1); }
    __builtin_amdgcn_sched_barrier(0);
#pragma unroll
    for (int nt = 0; nt < 2; ++nt) {
        f32x16 Ah, Rh, Gt, Rt2;
#pragma unroll
        for (int e = 0; e < 16; ++e) { Ah[e] = 0.f; Rh[e] = 0.f; Gt[e] = 0.f; Rt2[e] = 0.f; }
        const bf16x8 a0_ = SCRF(0, nt, 0), a1_ = SCRF(0, nt, 1);
        Ah = MF32(a0_, tF[0], Ah); Ah = MF32(a1_, tF[1], Ah);
        if (WMASK & 16) { *(bf16x8*)(ub + UB_AT + ((2 * nt + 0) * 64 + lane) * 16) = acc2frag(Ah, 0); *(bf16x8*)(ub + UB_AT + ((2 * nt + 1) * 64 + lane) * 16) = acc2frag(Ah, 1); }
        __builtin_amdgcn_sched_barrier(0);
        Rh = MF32(I0, SCRF(3, nt, 0), Rh); Rh = MF32(I1, SCRF(3, nt, 1), Rh); Rh = MF32(wn0, a0_, Rh); Rh = MF32(wn1, a1_, Rh);
        __builtin_amdgcn_sched_barrier(0);
        Gt = MF32(I0, SCRF(4, nt, 0), Gt); Gt = MF32(I1, SCRF(4, nt, 1), Gt); Gt = MF32(yn0, BTF(nt, 0), Gt); Gt = MF32(yn1, BTF(nt, 1), Gt);
        if (WMASK & 4) { *(bf16x8*)(ub + UB_KT + ((nt * 2 + 0) * 64 + lane) * 16) = acc2frag(Gt, 0); *(bf16x8*)(ub + UB_KT + ((nt * 2 + 1) * 64 + lane) * 16) = acc2frag(Gt, 1); }
        __builtin_amdgcn_sched_barrier(0);
        Rt2 = MF32(acc2frag(Rh, 0), I0, Rt2); Rt2 = MF32(acc2frag(Rh, 1), I1, Rt2);
        if (WMASK & 8) { *(bf16x8*)(ub + UB_QT + ((2 * nt + 0) * 64 + lane) * 16) = acc2frag(Rt2, 0); *(bf16x8*)(ub + UB_QT + ((2 * nt + 1) * 64 + lane) * 16) = acc2frag(Rt2, 1); }
    }
    LDS_WAIT(); asm volatile("" ::: "memory");
#undef TAU
#undef OKE
#undef SCRF
#undef BTF
}
template <int STAGE, int WMASK = 31>
__device__ __forceinline__ void rwkv_pre_waves(Frame& F, int l) {
    for (int it = F.gw; it < RW_ITEMS; it += F.NGW) { { int t_ = F.lane; asm volatile("" : "+v"(t_)); F.lane = t_; } const int c = it % NCH, bh = it / NCH; rwkv_pre_wave<STAGE, WMASK>(F, l, bh >> 3, bh & 7, c); }
}

#ifndef WC_NIF
#define WC_NIF 16
#endif
__device__ __forceinline__ void mix_scan(Frame& F, int l) {
    LAS float* scr = (LAS float*)(F.lds + RING_OFF + F.wave * 16384 + 12288);
    constexpr int NP_R = NB * 8 * 2, NP_GLR = 192, NP_C = NP_R + NP_GLR, NP_S = NB * 32;
    constexpr int NS_R = NS * 8, NS_H = NS * 8, NS_G = NS * 8, NS_S = NS * 32, NSA = NS_R + NS_H + NS_G + NS_S;
    { int t_ = F.lane; asm volatile("" : "+v"(t_)); F.lane = t_; }
    if (F.gw < NP_C) {
        const int r = F.gw;
        if (r < NP_R) { const int sl = r >> 5, u = r & 31; scan_rwkv_chunked(F, l, u >> 3, u & 7, sl); }
        else { const int q = r - NP_R, sl = q / 48, u = q % 48; scan_glr_item(F, l, u < 32 ? ((u >> 3) << 5) | (((u >> 1) & 3) << 3) | ((u & 1) << 2) | sl : 128 + (((u - 32) >> 2) << 4) | (((u - 32) & 3) << 2) | sl); }
        return;
    }
    const int w0 = F.gw - NP_C, ws_ = F.NGW - NP_C;
    if (w0 < NP_S) s5_carry(F, l, w0 >> 5, w0 & 31);
    for (int rp_ = 0; rp_ < DUPN(22); ++rp_)
    for (int it = w0; it < NSA; it += ws_) {
        { int t_ = F.lane; asm volatile("" : "+v"(t_)); F.lane = t_; }
        int r = it; const int sb = NB;
        if (r < NS_R) { scan_rwkv(F, l, sb + (r >> 3), r & 7, scr); continue; } r -= NS_R;
        if (r < NS_H) { scan_glr<128, true>(F, l, sb + (r >> 3), (r >> 1) & 3, r & 1, scr); continue; } r -= NS_H;
        if (r < NS_G) { scan_glr<64, false>(F, l, sb + (r >> 3), (r >> 1) & 3, r & 1, scr); continue; } r -= NS_G;
        scan_s5(F, l, sb + (r >> 5), r & 31);
    }
    for (int rp_ = 0; rp_ < DUPN(23); ++rp_) if (l + 1 < NL) weight_copies<WC_NIF>(F, l + 1, w0, ws_, (LAS float*)(F.lds + RING_OFF + F.wave * 16384));
}
__device__ __forceinline__ void unpack8(const v4u a, float (&o)[8]);
__device__ __forceinline__ void mix_post_a(Frame& F, int l) {
    const bf16* P = WSP(bf16, WS_P); const float* HS = WSP(float, WS_HS); const size_t st = (size_t)M * 2048;
    const float* C_re = GIN(28) + (size_t)l * 32768; const float* C_im = GIN(29) + (size_t)l * 32768; const float* Dv = GIN(30) + (size_t)l * 512;
    bf16* Y5 = WSP(bf16, WS_Y5);
    s5_ygemm(F, l);
    for (int row = MP + (F.NGW - 1 - F.gw); row < M; row += F.NGW) {
        const bf16* p = P + (size_t)row * INP;
#pragma unroll 1
        for (int j = 0; j < 8; ++j) {
            const int col = F.lane + 64 * j, g = col >> 4;
            const f32x4* hr = (const f32x4*)(HS + (size_t)row * 2048 + g * 64); const f32x4* hi = (const f32x4*)(HS + st + (size_t)row * 2048 + g * 64);
            const f32x4* cr = (const f32x4*)(C_re + (size_t)col * 64); const f32x4* ci = (const f32x4*)(C_im + (size_t)col * 64);
            float y = 0.f;
#pragma unroll
            for (int q = 0; q < 16; ++q) { const f32x4 a = hr[q], b = hi[q], c = cr[q], d = ci[q]; y += (a.x * c.x + a.y * c.y + a.z * c.z + a.w * c.w) - (b.x * d.x + b.y * d.y + b.z * d.z + b.w * d.w); }
            y += Dv[col] * bf2f(p[OFF_S + col]);
            Y5[(size_t)row * 512 + col] = (bf16)f2bf(gelu_tanh(y));
        }
    }
}
__device__ __forceinline__ void mix_post_b(Frame& F, int l, int w0, int wstride, int r0, int r1) {
    const bf16* P = WSP(bf16, WS_P); bf16* MIX = WSP(bf16, WS_MIX);
    const bf16* OH = WSP(bf16, WS_OH); const bf16* OG = WSP(bf16, WS_OG); const bf16* OH1 = WSP(bf16, WS_OH1);
    const float* ngh = GIN(34) + (size_t)l * 512; const float* ngg = GIN(37) + (size_t)l * 512;
    const f32x4 la = *(const f32x4*)(GIN(22) + (size_t)l * 512 + 8 * F.lane), lb2 = *(const f32x4*)(GIN(22) + (size_t)l * 512 + 8 * F.lane + 4);
    const f32x4 nh0 = *(const f32x4*)(ngh + 8 * F.lane), nh1 = *(const f32x4*)(ngh + 8 * F.lane + 4), ng0 = *(const f32x4*)(ngg + 8 * F.lane), ng1 = *(const f32x4*)(ngg + 8 * F.lane + 4);
    for (int row = r0 + w0; row < r1; row += wstride) {
        const bf16* p = P + (size_t)row * INP;
        if (row < MP) {
            const int c0 = 8 * F.lane; float y8[8], b8[8]; unpack8(*(const v4u*)(WSP(bf16, WS_RY) + (size_t)row * 512 + c0), y8); unpack8(*(const v4u*)(WSP(bf16, WS_RBV) + (size_t)row * 512 + c0), b8);
            const f32x4 ya = {y8[0], y8[1], y8[2], y8[3]}, yb = {y8[4], y8[5], y8[6], y8[7]}, ba = {b8[0], b8[1], b8[2], b8[3]}, bb = {b8[4], b8[5], b8[6], b8[7]};
            const v4u gw = *(const v4u*)(WSP(bf16, WS_RG) + (size_t)row * 512 + c0);
            float sm = (ya.x + ya.y + ya.z + ya.w) + (yb.x + yb.y + yb.z + yb.w);
            sm += __shfl_xor(sm, 1); sm += __shfl_xor(sm, 2); sm += __shfl_xor(sm, 4);
            const float mean = sm * (1.f / 64.f); const f32x4 da = ya - mean, db = yb - mean;
            float vr = (da.x * da.x + da.y * da.y + da.z * da.z + da.w * da.w) + (db.x * db.x + db.y * db.y + db.z * db.z + db.w * db.w);
            vr += __shfl_xor(vr, 1); vr += __shfl_xor(vr, 2); vr += __shfl_xor(vr, 4);
            const float rs = rsqrtf(vr * (1.f / 64.f) + 64e-5f);
            const f32x4 oa = da * rs * la + ba, ob = db * rs * lb2 + bb;
            v4u w; w.x = pk2(oa.x * bflo(gw.x), oa.y * bfhi(gw.x)); w.y = pk2(oa.z * bflo(gw.y), oa.w * bfhi(gw.y)); w.z = pk2(ob.x * bflo(gw.z), ob.y * bfhi(gw.z)); w.w = pk2(ob.z * bflo(gw.w), ob.w * bfhi(gw.w));
            *(v4u*)(MIX + (size_t)row * D + c0) = w;
        }
        {
            const int c0 = 8 * F.lane;
            float oh[8], og[8];
            unpack8(*(const v4u*)(OH + (size_t)row * 512 + c0), oh);
            if (row < MP) { float o1[8]; unpack8(*(const v4u*)(OH1 + (size_t)row * 512 + c0), o1);
#pragma unroll
                for (int j = 0; j < 8; ++j) oh[j] += o1[j]; }
            unpack8(*(const v4u*)(OG + (size_t)row * 512 + c0), og);
            float gh[8], gg[8]; unpack8(*(const v4u*)(p + OFF_H + 1536 + c0), gh); unpack8(*(const v4u*)(p + OFF_G + 1040 + c0), gg);
            float sh = 0.f, sg = 0.f;
#pragma unroll
            for (int j = 0; j < 8; ++j) { sh += oh[j] * oh[j]; sg += og[j] * og[j]; }
#pragma unroll
            for (int o = 1; o < 16; o <<= 1) { sh += __shfl_xor(sh, o); sg += __shfl_xor(sg, o); }
            const float rh = rsqrtf(sh * (1.f / 128.f) + EPS), rg = rsqrtf(sg * (1.f / 128.f) + EPS);
            const float nh[8] = {nh0.x, nh0.y, nh0.z, nh0.w, nh1.x, nh1.y, nh1.z, nh1.w}, ngv[8] = {ng0.x, ng0.y, ng0.z, ng0.w, ng1.x, ng1.y, ng1.z, ng1.w};
            float yh[8], yg[8];
#pragma unroll
            for (int j = 0; j < 8; ++j) { yh[j] = oh[j] * rh * nh[j] * gh[j] * __builtin_amdgcn_rcpf(1.f + __expf(-gh[j])); yg[j] = og[j] * rg * ngv[j] * gg[j] * __builtin_amdgcn_rcpf(1.f + __expf(-gg[j])); }
            *(v4u*)(MIX + (size_t)row * D + 1024 + c0) = (v4u){pk2(yh[0], yh[1]), pk2(yh[2], yh[3]), pk2(yh[4], yh[5]), pk2(yh[6], yh[7])};
            *(v4u*)(MIX + (size_t)row * D + 1536 + c0) = (v4u){pk2(yg[0], yg[1]), pk2(yg[2], yg[3]), pk2(yg[4], yg[5]), pk2(yg[6], yg[7])};
        }
    }
}
__device__ __forceinline__ float gelu_fast(float x) { const float u = -1.5957691216057308f * (x + 0.044715f * x * x * x); return x * __builtin_amdgcn_rcpf(1.f + __expf(u)); }
__device__ __forceinline__ void unpack8(const v4u a, float (&o)[8]) { o[0] = bflo(a.x); o[1] = bfhi(a.x); o[2] = bflo(a.y); o[3] = bfhi(a.y); o[4] = bflo(a.z); o[5] = bfhi(a.z); o[6] = bflo(a.w); o[7] = bfhi(a.w); }
template <int R>
__device__ __forceinline__ void conv_run(Frame& F, int l, int first, int s, int t0, int n) {
    const bf16* U = WSP(bf16, WS_U); bf16* ACT = WSP(bf16, WS_ACT);
    const float* buf_in = GIN(8) + (size_t)l * NS * 2 * FF; const float* cw = GIN(40) + (size_t)l * 3 * FF; const float* cb = GIN(41) + (size_t)l * FF;
    const bf16* ur = U + (size_t)first * FF2 + n;
    v4u ru[R], rg[R], rh1 = {0u, 0u, 0u, 0u}, rh2 = {0u, 0u, 0u, 0u}; f32x4 fb[2][2];
#pragma unroll
    for (int i = 0; i < R; ++i) { ru[i] = *(const v4u*)(ur + (size_t)i * FF2); rg[i] = *(const v4u*)(ur + (size_t)i * FF2 + FF); }
    if (t0 >= 1) rh1 = *(const v4u*)(ur - FF2);
    if (t0 >= 2) rh2 = *(const v4u*)(ur - 2 * FF2);
    const bool smp = s >= NB;
    if (smp && t0 < 2) {
#pragma unroll
        for (int j = 0; j < 2; ++j) { const f32x4* bp = (const f32x4*)(buf_in + ((size_t)(s - NB) * 2 + j) * FF + n); fb[j][0] = bp[0]; fb[j][1] = bp[1]; } }
    f32x4 w0[2], w1[2], w2[2], bb[2];
#pragma unroll
    for (int hq = 0; hq < 2; ++hq) { w0[hq] = ((const f32x4*)(cw + n))[hq]; w1[hq] = ((const f32x4*)(cw + FF + n))[hq]; w2[hq] = ((const f32x4*)(cw + 2 * FF + n))[hq]; bb[hq] = ((const f32x4*)(cb + n))[hq]; }
    float h1[8], h2[8];
    unpack8(rh1, h1); unpack8(rh2, h2);
    if (smp && t0 < 2) {
#pragma unroll
        for (int j = 0; j < 8; ++j) { const float s1 = fb[1][j >> 2][j & 3], s0 = fb[0][j >> 2][j & 3]; if (t0 == 0) { h1[j] = s1; h2[j] = s0; } else h2[j] = s1; } }
#pragma unroll
    for (int i = 0; i < R; ++i) {
        float u0[8], gg[8], o[8]; unpack8(ru[i], u0); unpack8(rg[i], gg);
#pragma unroll
        for (int j = 0; j < 8; ++j) { const float c = bb[j >> 2][j & 3] + w0[j >> 2][j & 3] * h2[j] + w1[j >> 2][j & 3] * h1[j] + w2[j >> 2][j & 3] * u0[j]; o[j] = gelu_fast(c) * gg[j]; }
        *(v4u*)(ACT + (size_t)(first + i) * FF + n) = (v4u){pk2(o[0], o[1]), pk2(o[2], o[3]), pk2(o[4], o[5]), pk2(o[6], o[7])};
        if (smp && t0 + i >= TS - 2) { float* bo = F.out + O_CVS + (((size_t)l * NS + (s - NB)) * 2 + (t0 + i - (TS - 2))) * FF + n;
            *(f32x4*)bo = (f32x4){u0[0], u0[1], u0[2], u0[3]}; *(f32x4*)(bo + 4) = (f32x4){u0[4], u0[5], u0[6], u0[7]}; }
#pragma unroll
        for (int j = 0; j < 8; ++j) { h2[j] = h1[j]; h1[j] = u0[j]; }
    }
}
__device__ __forceinline__ void conv_rows(Frame& F, int l) {
    constexpr int NA = MP / 64, NBS = NB - 1, NCS = NS, NRUN = NA + NBS + NCS, NCB = (FF + 511) / 512;
    static_assert(MP % 64 == 0 && TS == 4 && (TP % 64) != 63 && (TP % 64) != 0, "prompt rows in 64-row blocks; sample sequences of 4 rows; a 64-row block never starts on the second row of a sequence");
    for (int it = F.gw; it < NRUN * NCB; it += F.NGW) {
        int ln = F.lane; asm volatile("" : "+v"(ln));
        const int idx = it / NCB, cbk = it % NCB, n = cbk * 512 + ln * 8;
        if (n >= FF) continue;
        if (idx < NA) { const int first = 64 * idx; conv_run<2>(F, l, first, first / TP, first % TP, n); }
        else if (idx < NA + NBS) { const int b = idx - NA + 1; conv_run<2>(F, l, b * TP, b, 0, n); }
        else { const int sq = idx - NA - NBS; conv_run<4>(F, l, MP + 4 * sq, NB + sq, 0, n); }
    }
}
#ifndef PROBE_DUP
#define PROBE_DUP 0
#endif
#ifndef RWMASK
#define RWMASK 24
#endif

#ifndef POSTB_SPLIT
#define POSTB_SPLIT 3072
#endif
constexpr int NPH_L = 12, PH_FINAL = 1 + NL * NPH_L, NPHASES = PH_FINAL + 1;
struct Args { const float* in[44]; float* out; unsigned char* ws; int ph_lo, ph_hi; };
__global__ void __launch_bounds__(NTHR, 2) fwd(Args args) {
    extern __shared__ __attribute__((aligned(16))) unsigned char lds[];
    Frame F;
    F.lds = (LAS unsigned char*)lds;
    F.MISC = (volatile LAS unsigned*)(F.lds + MISC_OFF);
    F.tid = threadIdx.x; F.lane = F.tid & 63; F.wave = __builtin_amdgcn_readfirstlane(F.tid >> 6);
    const int wv0 = F.wave;
    F.G = gridDim.x; F.gw = F.wave * F.G + blockIdx.x; F.NGW = F.G * NWAVES;
    F.in = args.in; F.out = args.out; F.ws = args.ws; F.ctl = (unsigned*)(args.ws + WS_CTL);
    for (int u = F.tid; u < (LDS_BYTES - LDSCTL_OFF) / 4; u += NTHR) ((LAS unsigned*)(F.lds + LDSCTL_OFF))[u] = 0u;
    __syncthreads();
    XcdBarrier bar; bar.bar = F.ctl + CW_BAR; bar.x = 0; bar.st = nullptr; bar.wv = wv0;
    if (!MK_PER_PHASE) bar = xcd_barrier_post(F.ctl + CW_BAR, F.MISC + 8, wv0);
    const int lo = args.ph_lo, hi = args.ph_hi;
    bf16 *X, *XN, *P, *MIX, *U, *ACT;
#define IN(k) (!MK_PER_PHASE || (lo <= (k) && (k) < hi))
#define PB() do { int w0_ = wv0; asm volatile("" : "+s"(w0_)); const int t_ = w0_ * 64 + pg8::lane_id(); F.tid = t_; F.lane = t_ & 63; F.wave = w0_; { int g_ = (int)gridDim.x; asm volatile("" : "+s"(g_)); F.G = g_; F.NGW = g_ * NWAVES; } F.gw = F.wave * F.G + (int)blockIdx.x; \
    { GAS unsigned char* w_ = (GAS unsigned char*)args.ws; asm volatile("" : "+s"(w_)); F.ws = (unsigned char*)w_; GAS float* o_ = (GAS float*)args.out; asm volatile("" : "+s"(o_)); F.out = (float*)o_; } \
    X = WSP(bf16, WS_X); XN = WSP(bf16, WS_XN); P = WSP(bf16, WS_P); MIX = WSP(bf16, WS_MIX); U = WSP(bf16, WS_U); ACT = WSP(bf16, WS_ACT); } while (0)
#define SEAM(k) do { if (!MK_PER_PHASE) { XcdBarrier b2_ = bar; asm volatile("" : "+s"(b2_.bar), "+s"(b2_.x), "+s"(b2_.wv)); xcd_barrier(b2_); } } while (0)
    if (IN(0)) { for (int rep_ = 0; rep_ < DUPN(11); ++rep_) { PB(); p0_prologue(F); if (rep_ + 1 < DUPN(11)) { VM_WAIT(); __syncthreads(); } } SEAM(0); }
    for (int l = 0; l < NL; ++l) {
        const int pb = 1 + l * NPH_L;
        if (IN(pb + 1)) { PB();
            if (l > 0 && (int)blockIdx.x < NB_OUTB) { pg8::Gemm g{ACT + (size_t)MA_IN * FF, WSP(bf16, WS_WDN) + (size_t)(l - 1) * D * FF, MPAD - MA_IN, D, FF}; pg8::StaticOrder S; S.init(MPAD - MA_IN, D, NB_OUTB, (int)blockIdx.x);
                pg8::EpiResid<true> E{X + (size_t)MA_IN * D, D, FF / 64, nullptr, WSP(float, WS_SSQ) + (size_t)MA_IN * 32};
                pg8::gemm_phase<pg8::EpiResid<true>, pg8::StaticOrder, true, true>(F.lds + RING_OFF, g, S, E, F.wave); }
            else { pg8::Gemm g{X, WSP(bf16, WS_WIN) + (size_t)l * INP * D, MPAD, INP, D}; pg8::ChainOrder S; S.init(INP, F.G, (int)blockIdx.x, 0, 3, l > 0 ? NB_OUTB : 0, 3, 1); pg8::EpiStoreBf16S E{P, INP, WSP(float, WS_SSQ)};
                pg8::gemm_phase<pg8::EpiStoreBf16S, pg8::ChainOrder, true, true>(F.lds + RING_OFF, g, S, E, F.wave); }
            SEAM(pb + 1); }
        const int nin2 = NB_IN + (l > 0 ? 3 * NB_OUTB : 0), niw = (F.G - nin2) * 8 < 1472 ? (F.G - nin2) * 8 : 1472;
        if (IN(pb + 2)) { PB();
            if ((int)blockIdx.x < nin2) { pg8::Gemm g{X, WSP(bf16, WS_WIN) + (size_t)l * INP * D, MPAD, INP, D}; pg8::ChainOrder S; S.init(INP, F.G, (int)blockIdx.x, 1, 3, l > 0 ? NB_OUTB : 0, 3, 1); pg8::EpiStoreBf16S E{P, INP, WSP(float, WS_SSQ)};
                pg8::gemm_phase<pg8::EpiStoreBf16S, pg8::ChainOrder, true, true>(F.lds + RING_OFF, g, S, E, F.wave); }
            else glr_pre(F, l, 0, (int)blockIdx.x - nin2, F.G - nin2, niw);
            SEAM(pb + 2); }
        if (IN(pb + 3)) { for (int rep_ = 0; rep_ < DUPN(2); ++rep_) { PB(); { const int nbusy = RW_ITEMS > F.NGW ? (RW_ITEMS - F.NGW < F.G / 2 ? RW_ITEMS - F.NGW : 0) : 0; if ((int)blockIdx.x >= nbusy) glr_pre(F, l, 1, F.G - 1 - (int)blockIdx.x, F.G - nbusy, niw); }        for (int r2_ = 0; r2_ < DUPN(13); ++r2_) { rwkv_pre_waves<2, 31>(F, l); __syncthreads(); } for (int r2_ = 0; r2_ < DUPN(14); ++r2_) { mix_pre(F, l); __syncthreads(); } s5_egemm(F, l); if (rep_ + 1 < DUPN(2)) { VM_WAIT(); __syncthreads(); } } SEAM(pb + 3); }
        if (IN(pb + 4)) { for (int rep_ = 0; rep_ < DUPN(3); ++rep_) { PB(); mix_scan(F, l); if (rep_ + 1 < DUPN(3)) { VM_WAIT(); __syncthreads(); } } SEAM(pb + 4); }
        if (IN(pb + 5)) { for (int rep_ = 0; rep_ < DUPN(4); ++rep_) { PB(); mix_post_a(F, l); mix_post_b(F, l, F.gw, F.NGW, 0, POSTB_SPLIT);        if (rep_ + 1 < DUPN(4)) { VM_WAIT(); __syncthreads(); } } SEAM(pb + 5); }
        if (IN(pb + 6)) { for (int rep_ = 0; rep_ < DUPN(5); ++rep_) { PB(); pg8::Gemm g{WSP(bf16, WS_Y5), WSP(bf16, WS_WGLUT) + (size_t)l * 512 * 512, MPAD, 512, 512}; pg8::StaticOrder S; S.init(MPAD, 512, F.G, (int)blockIdx.x);
            pg8::EpiGlu E{MIX + 512, D, WSP(bf16, WS_Y5), 512, GIN(32) + (size_t)l * 512};
            pg8::gemm_phase<pg8::EpiGlu, pg8::StaticOrder, true, true>(F.lds + RING_OFF, g, S, E, F.wave);
            { constexpr int NGLU = (MPAD / 256) * 2; if ((int)blockIdx.x >= NGLU) mix_post_b(F, l, F.wave * (F.G - NGLU) + ((int)blockIdx.x - NGLU), (F.G - NGLU) * NWAVES, POSTB_SPLIT, M); } if (rep_ + 1 < DUPN(5)) { VM_WAIT(); __syncthreads(); } } SEAM(pb + 6); }
        if (IN(pb + 7)) { PB(); pg8::Gemm g{MIX, WSP(bf16, WS_WOUT) + (size_t)l * D * D, MA_IN, D, D}; pg8::StaticOrder S; S.init(MA_IN, D, F.G, (int)blockIdx.x); pg8::EpiResid<true> E{X, D, D / 64, nullptr, WSP(float, WS_SSQ)};
            pg8::gemm_phase<pg8::EpiResid<true>, pg8::StaticOrder, true, true>(F.lds + RING_OFF, g, S, E, F.wave); SEAM(pb + 7); }
        if (IN(pb + 8)) { PB();
            if ((int)blockIdx.x < NB_OUTB) { pg8::Gemm g{MIX + (size_t)MA_IN * D, WSP(bf16, WS_WOUT) + (size_t)l * D * D, MPAD - MA_IN, D, D}; pg8::StaticOrder S; S.init(MPAD - MA_IN, D, NB_OUTB, (int)blockIdx.x);
                pg8::EpiResid<true> E{X + (size_t)MA_IN * D, D, D / 64, nullptr, WSP(float, WS_SSQ) + (size_t)MA_IN * 32};
                pg8::gemm_phase<pg8::EpiResid<true>, pg8::StaticOrder, true, true>(F.lds + RING_OFF, g, S, E, F.wave); VM_WAIT(); __syncthreads(); PB(); }
            { pg8::Gemm g{X, WSP(bf16, WS_WUP) + (size_t)l * FF2 * D, MPAD, FF2, D}; pg8::ChainOrder S; S.init(FF2, F.G, (int)blockIdx.x, 0, UP1_ROUNDS, NB_OUTB, 1, 0); pg8::EpiConvAct E{ACT, U, GIN(40) + (size_t)l * 3 * FF, GIN(41) + (size_t)l * FF, F.out + O_CVP + (size_t)l * NB * 2 * FF, WSP(float, WS_SSQ)};
              pg8::gemm_phase<pg8::EpiConvAct, pg8::ChainOrder, true, true>(F.lds + RING_OFF, g, S, E, F.wave); }
            SEAM(pb + 8); }
        if (IN(pb + 9)) { PB(); pg8::Gemm g{X, WSP(bf16, WS_WUP) + (size_t)l * FF2 * D, MPAD, FF2, D}; pg8::ChainOrder S; S.init(FF2, F.G, (int)blockIdx.x, 1, UP1_ROUNDS, NB_OUTB, 1, 0); pg8::EpiConvAct E{ACT, U, GIN(40) + (size_t)l * 3 * FF, GIN(41) + (size_t)l * FF, F.out + O_CVP + (size_t)l * NB * 2 * FF, WSP(float, WS_SSQ)};
            pg8::gemm_phase<pg8::EpiConvAct, pg8::ChainOrder, true, true>(F.lds + RING_OFF, g, S, E, F.wave); SEAM(pb + 9); }
        if (IN(pb + 10)) { for (int rep_ = 0; rep_ < DUPN(9); ++rep_) { PB(); conv_rows(F, l); if (rep_ + 1 < DUPN(9)) { VM_WAIT(); __syncthreads(); } } SEAM(pb + 10); }
        if (IN(pb + 11)) { PB();
            if (l + 1 < NL) { pg8::Gemm g{ACT, WSP(bf16, WS_WDN) + (size_t)l * D * FF, MA_IN, D, FF}; pg8::StaticOrder S; S.init(MA_IN, D, F.G, (int)blockIdx.x); pg8::EpiResid<true> E{X, D, FF / 64, nullptr, WSP(float, WS_SSQ)};
                pg8::gemm_phase<pg8::EpiResid<true>, pg8::StaticOrder, true, true>(F.lds + RING_OFF, g, S, E, F.wave); }
            else { pg8::Gemm g{ACT, WSP(bf16, WS_WDN) + (size_t)l * D * FF, MPAD, D, FF}; pg8::SplitTailOrder S; S.init2(MPAD, D, FF, F.G, (int)blockIdx.x); pg8::EpiResid<false> E{X, D, FF / 64, WSP(float, WS_SLAB), nullptr};
                pg8::gemm_phase<pg8::EpiResid<false>, pg8::SplitTailOrder, true, true>(F.lds + RING_OFF, g, S, E, F.wave); }
            SEAM(pb + 11); }
    }
    if (IN(PH_FINAL)) { PB(); final_rows(F, X, GIN(43), F.out); }
#undef IN
#undef SEAM
}

extern "C" void kernel_launch(void* const* d_in, const int* in_sizes, int n_in, void* d_out, int out_size, void* d_ws, size_t ws_size, hipStream_t stream) {
    static int grid = 0;
    if (grid == 0) {
        if (n_in != 44 || (size_t)out_size != O_END || ws_size < WS_END) { fprintf(stderr, "kernel_launch: built for 44 inputs, %zu outputs, >= %zu bytes of workspace; got %d, %d, %zu; nothing launched\n", (size_t)O_END, (size_t)WS_END, n_in, out_size, ws_size); grid = -1; return; }
        int dev = 0, cus = 0, per_cu = 0;
        if (hipGetDevice(&dev) != hipSuccess || hipDeviceGetAttribute(&cus, hipDeviceAttributeMultiprocessorCount, dev) != hipSuccess) { fprintf(stderr, "kernel_launch: device query failed\n"); grid = -1; return; }
        if (hipFuncSetAttribute((const void*)fwd, hipFuncAttributeMaxDynamicSharedMemorySize, LDS_BYTES) != hipSuccess) { fprintf(stderr, "kernel_launch: hipFuncSetAttribute failed\n"); grid = -1; return; }
        if (hipOccupancyMaxActiveBlocksPerMultiprocessor(&per_cu, (const void*)fwd, NTHR, LDS_BYTES) != hipSuccess || per_cu < 1) fprintf(stderr, "kernel_launch: note: occupancy query reports %d workgroups per CU\n", per_cu);
        (void)hipGetLastError();
        grid = cus;
    }
    if (grid < 0) return;
    if (hipMemsetAsync((char*)d_ws + WS_CTL, 0, CTL_ZERO_BYTES, stream) != hipSuccess) { fprintf(stderr, "kernel_launch: memset failed\n"); return; }
    Args a{};
    for (int i = 0; i < 44; ++i) a.in[i] = (const float*)d_in[i];
    a.out = (float*)d_out; a.ws = (unsigned char*)d_ws;
#if MK_PER_PHASE
    for (int ph = 0; ph < NPHASES; ++ph) { a.ph_lo = ph; a.ph_hi = ph + 1; hipLaunchKernelGGL(fwd, dim3(grid), dim3(NTHR), LDS_BYTES, stream, a); }
#else
    a.ph_lo = 0; a.ph_hi = NPHASES; hipLaunchKernelGGL(fwd, dim3(grid), dim3(NTHR), LDS_BYTES, stream, a);
#endif
    const hipError_t le = hipPeekAtLastError();
    if (le != hipSuccess) fprintf(stderr, "kernel_launch: launch failed: %s\n", hipGetErrorName(le));
}
```
